# Optimizing an MI355X kernel written in HIP

```python
import jax, jax.numpy as jnp
from jax import lax
import numpy as np

D_MODEL = 4096
BATCH = 4
SEQ = 4096
DEPTH = 1

MIX_WIDTH = D_MODEL
HEAD_DIM = 128
A_WIDTH = MIX_WIDTH // 2
A_HEADS = A_WIDTH // HEAD_DIM
A_KEY_DIM = 128
A_KEY_WIDTH = A_HEADS * A_KEY_DIM
B_WIDTH = MIX_WIDTH - A_WIDTH
B_GROUP_DIM = 128
B_GROUPS = B_WIDTH // B_GROUP_DIM
GMLP_CHUNK = 128
GLA_CHUNK = 64
IN_COLS = 2 * A_KEY_WIDTH + 2 * A_WIDTH + 2 * B_WIDTH
D_FF = ((8 * D_MODEL + 3 * 256 - 1) // (3 * 256)) * 256
PLE_DIM = 256
EPS = 1e-6

kernel_name = "hymba_hgrn2_gmlp_hybrid"


def _rmsnorm(x, w):
    xf = x.astype(jnp.float32)
    y = xf * lax.rsqrt(jnp.mean(xf * xf, axis=-1, keepdims=True) + EPS)
    return (y * w.astype(jnp.float32)).astype(x.dtype)


def _hgrn2(q, f_pre, i_in, g, lb, norm_w):
    bsz, t, _ = q.shape
    n = t // GLA_CHUNK
    f32 = jnp.float32
    lbf = lb.astype(f32)
    qf = jax.nn.silu(q.astype(f32))
    f = lbf + (1.0 - lbf) * jax.nn.sigmoid(f_pre.astype(f32))
    kf = 1.0 - f
    logf = jnp.log(jnp.maximum(f, 1e-30))

    def to_chunks(a, d):
        return a.reshape(bsz, n, GLA_CHUNK, A_HEADS, d).transpose(1, 0, 3, 2, 4)

    qc = to_chunks(qf, A_KEY_DIM)
    kc = to_chunks(kf, A_KEY_DIM)
    vc = to_chunks(i_in.astype(f32), HEAD_DIM)
    bc = jnp.cumsum(to_chunks(logf, A_KEY_DIM), axis=3)
    causal = jnp.tril(jnp.ones((GLA_CHUNK, GLA_CHUNK), dtype=bool))[:, :, None]

    def step(state, inp):
        q_c, k_c, v_c, b_c = inp
        inter = jnp.einsum('bhtk,bhkv->bhtv', q_c * jnp.exp(b_c), state)
        diff = b_c[:, :, :, None, :] - b_c[:, :, None, :, :]
        decay = jnp.exp(jnp.where(causal, diff, -jnp.inf))
        scores = jnp.einsum('bhtk,bhsk,bhtsk->bhts', q_c, k_c, decay)
        intra = jnp.einsum('bhts,bhsv->bhtv', scores, v_c)
        b_end = b_c[:, :, -1:, :]
        new_state = (jnp.exp(b_end[:, :, 0, :])[..., None] * state
                     + jnp.einsum('bhsk,bhsv->bhkv', k_c * jnp.exp(b_end - b_c), v_c))
        return new_state, inter + intra

    s0 = jnp.zeros((bsz, A_HEADS, A_KEY_DIM, HEAD_DIM), f32)
    _, o = lax.scan(step, s0, (qc, kc, vc, bc))
    o = o.transpose(1, 0, 3, 2, 4).reshape(bsz, t, A_HEADS, HEAD_DIM)
    o = o * lax.rsqrt(jnp.mean(o * o, axis=-1, keepdims=True) + EPS)
    o = o.reshape(bsz, t, A_WIDTH) * norm_w.astype(f32) * jax.nn.silu(g.astype(f32))
    return o.astype(q.dtype)


def _gmlp(u, v, ln_w, ln_b, w_s, b_s):
    bsz, t, _ = u.shape
    n = t // GMLP_CHUNK
    f32 = jnp.float32
    uf = jax.nn.gelu(u.astype(f32), approximate=False)
    vf = jax.nn.gelu(v.astype(f32), approximate=False)
    mu = jnp.mean(vf, axis=-1, keepdims=True)
    var = jnp.mean(jnp.square(vf - mu), axis=-1, keepdims=True)
    vf = (vf - mu) * lax.rsqrt(var + EPS) * ln_w.astype(f32) + ln_b.astype(f32)
    vc = vf.reshape(bsz, n, GMLP_CHUNK, B_GROUPS, B_GROUP_DIM)
    tril = jnp.tril(jnp.ones((GMLP_CHUNK, GMLP_CHUNK), f32))
    w = w_s.astype(f32) * tril
    z = jnp.einsum('gts,bnsgd->bntgd', w, vc) + b_s.astype(f32).T[None, None, :, :, None]
    return (uf * z.reshape(bsz, t, B_WIDTH)).astype(u.dtype)


def setup_inputs(seed: int = 0) -> dict:
    key = jax.random.key(seed)
    ks = jax.random.split(key, 20)
    nrm = jax.random.normal
    f32 = jnp.float32

    def gain(k, shape):
        return 1.0 + 0.01 * nrm(k, shape, f32)

    return {
        "x": nrm(ks[0], (BATCH, SEQ, D_MODEL), f32),
        "p": nrm(ks[1], (DEPTH, BATCH, SEQ, PLE_DIM), f32),
        "pre_mix_w": gain(ks[2], (DEPTH, D_MODEL)),
        "w_in": nrm(ks[3], (DEPTH, D_MODEL, IN_COLS), f32) * D_MODEL ** -0.5,
        "lb_param": nrm(ks[4], (DEPTH + 1, A_KEY_WIDTH), f32) * 0.5,
        "a_norm_w": gain(ks[5], (DEPTH, A_WIDTH)),
        "gmlp_ln_w": gain(ks[6], (DEPTH, B_WIDTH)),
        "gmlp_ln_b": 0.01 * nrm(ks[7], (DEPTH, B_WIDTH), f32),
        "w_spatial": nrm(ks[8], (DEPTH, B_GROUPS, GMLP_CHUNK, GMLP_CHUNK), f32) * GMLP_CHUNK ** -0.5,
        "b_spatial": gain(ks[9], (DEPTH, B_GROUPS, GMLP_CHUNK)),
        "w_out": nrm(ks[10], (DEPTH, MIX_WIDTH, D_MODEL), f32) * MIX_WIDTH ** -0.5,
        "post_mix_w": gain(ks[11], (DEPTH, D_MODEL)),
        "pre_ffn_w": gain(ks[12], (DEPTH, D_MODEL)),
        "w_gate": nrm(ks[13], (DEPTH, D_MODEL, D_FF), f32) * D_MODEL ** -0.5,
        "w_up": nrm(ks[14], (DEPTH, D_MODEL, D_FF), f32) * D_MODEL ** -0.5,
        "w_down": nrm(ks[15], (DEPTH, D_FF, D_MODEL), f32) * D_FF ** -0.5,
        "post_ffn_w": gain(ks[16], (DEPTH, D_MODEL)),
        "w_ple": nrm(ks[17], (DEPTH, PLE_DIM, D_MODEL), f32) * PLE_DIM ** -0.5,
        "w_ple_gate": nrm(ks[18], (DEPTH, D_MODEL, D_MODEL), f32) * D_MODEL ** -0.5,
        "post_ple_w": gain(ks[19], (DEPTH, D_MODEL)),
    }


def reference(x, p, pre_mix_w, w_in, lb_param, a_norm_w, gmlp_ln_w, gmlp_ln_b, w_spatial, b_spatial,
              w_out, post_mix_w, pre_ffn_w, w_gate, w_up, w_down, post_ffn_w, w_ple, w_ple_gate, post_ple_w):
    lower_bounds = jnp.cumsum(jax.nn.softmax(lb_param.astype(jnp.float32), axis=0), axis=0)
    splits = [A_KEY_WIDTH,
              2 * A_KEY_WIDTH,
              2 * A_KEY_WIDTH + A_WIDTH,
              2 * A_KEY_WIDTH + 2 * A_WIDTH,
              2 * A_KEY_WIDTH + 2 * A_WIDTH + B_WIDTH]
    for l in range(DEPTH):
        h = _rmsnorm(x, pre_mix_w[l])
        proj = h @ w_in[l]
        q, f_pre, i_in, g, u, v = jnp.split(proj, splits, axis=-1)
        a_out = _hgrn2(q, f_pre, i_in, g, lower_bounds[l], a_norm_w[l])
        b_out = _gmlp(u, v, gmlp_ln_w[l], gmlp_ln_b[l], w_spatial[l], b_spatial[l])
        mix = jnp.concatenate([a_out, b_out], axis=-1) @ w_out[l]
        x = x + _rmsnorm(mix, post_mix_w[l])
        h = _rmsnorm(x, pre_ffn_w[l])
        ff = (jax.nn.silu(h @ w_gate[l]) * (h @ w_up[l])) @ w_down[l]
        x = x + _rmsnorm(ff, post_ffn_w[l])
        gate = jax.nn.sigmoid(x @ w_ple_gate[l])
        x = x + _rmsnorm((p[l] @ w_ple[l]) * gate, post_ple_w[l])
    return x
```

```cpp
#include <hip/hip_runtime.h>
#include <cstdio>
#include <cstdint>
namespace pg8 {
#define PG8_LAS __attribute__((address_space(3)))
typedef unsigned short bf16_t;
typedef short bf16x8 __attribute__((ext_vector_type(8)));
typedef float f32x4 __attribute__((ext_vector_type(4)));
typedef unsigned u32x4 __attribute__((ext_vector_type(4)));
constexpr int BM = 256, BK = 64, HALF = 128, HTB = HALF * BK * 2  , STAGE_BYTES = 8 * HTB, NXCD = 8, WGM = 8;

__host__ __device__ __forceinline__ int lds_byte(int r, int c) { const int st = (r >> 4) * 2 + (c >> 5), rr = r & 15, cc = c & 31, ob = rr * 64 + cc * 2; return st * 1024 + (ob ^ (((ob >> 9) & 1) << 5)); }
__host__ __device__ __forceinline__ void stage_rc(int b, int& R, int& C) { const int st = b / 1024, sb = b % 1024, swz = sb ^ (((sb >> 9) & 1) << 5); R = (st >> 1) * 16 + swz / 64; C = (st & 1) * 32 + (swz % 64) / 2; }
__host__ __device__ __forceinline__ int perm32(int rho) { const int n = rho >> 4, i = rho & 15; return 8 * (i >> 2) + 4 * n + (i & 3); }

struct Unit { int pm, pn; };
struct Gemm { const bf16_t* A; const bf16_t* Bt; int M, N, K; };

struct StaticOrder {
    int nM, nN, nwg, G, c;
    __host__ __device__ void init(int M, int N, int G_, int c_) { nM = M / BM; nN = N / BM; nwg = nM * nN; G = G_; c = c_; }
    __host__ __device__ bool next(int i, Unit& u) const {
        const long L = (long)i * G + c; if (L >= nwg) return false;
        int wgid = (int)L; { const int q = nwg / NXCD, r = nwg % NXCD, xcd = wgid % NXCD, off = wgid / NXCD; wgid = (xcd < r ? xcd * (q + 1) : r * (q + 1) + (xcd - r) * q) + off; }
        const int nig = WGM * nN, gid = wgid / nig, fm = gid * WGM, gsz = (nM - fm) < WGM ? (nM - fm) : WGM;
        u.pm = fm + ((wgid % nig) % gsz); u.pn = (wgid % nig) / gsz; return true;
    }
    __device__ __forceinline__ void a_ready(const Unit&) const {}
    __device__ __forceinline__ void done(const Unit&) const {}
};

__device__ __forceinline__ unsigned cvt_pk_bf16(float lo, float hi) { unsigned r; asm volatile("v_cvt_pk_bf16_f32 %0, %1, %2" : "=v"(r) : "v"(lo), "v"(hi)); return r; }
typedef float f32x2 __attribute__((ext_vector_type(2)));
__device__ __forceinline__ f32x2 gelu_pk(f32x2 v) {
    const f32x2 av = __builtin_elementwise_abs(v), d = av * 0.2316418882f + 1.0f;
    f32x2 t; t.x = __builtin_amdgcn_rcpf(d.x); t.y = __builtin_amdgcn_rcpf(d.y);
    f32x2 q = t * 0.5307027145f + (-0.7265760135f); q = q * t + 0.7107068705f; q = q * t + (-0.142248368f); q = q * t + 0.127414796f; q = q * t;
    const f32x2 s = (v * v) * (-0.72134752044f);
    f32x2 e; e.x = __builtin_amdgcn_exp2f(s.x); e.y = __builtin_amdgcn_exp2f(s.y);
    const f32x2 m = v * (q * e), r = v - m;
    f32x2 o; o.x = v.x < 0.f ? m.x : r.x; o.y = v.y < 0.f ? m.y : r.y; return o;
}

template <int ACT  > struct EpiBf16 {
    static constexpr bool PERM = true, AFTER_DRAIN = false; static_assert(ACT == 0 || ACT == 1, "EpiBf16: ACT is 0 (none) or 1 (gelu_pk)");
    bf16_t* O; int ldc; const float* bias; int split_cols; size_t split_stride; float scale0;
    __device__ __forceinline__ void operator()(const f32x4 (&acc)[2][2][4][2], const Unit& u, int wr, int wc, int fr, int fq) const {
        const int row0 = u.pm * BM + wr * 64 + fr; int colt = u.pn * BM; bf16_t* base = O;
        float sc = 1.f; if (split_cols) { const int t = colt / split_cols; base += (size_t)t * split_stride; colt -= t * split_cols; if (t == 0) sc = scale0; }
        const int col0 = colt + wc * 32 + 8 * fq, bcol0 = u.pn * BM + wc * 32 + 8 * fq;
        f32x4 bv[2][2];
#pragma unroll
        for (int bj = 0; bj < 2; ++bj)
#pragma unroll
            for (int n = 0; n < 2; ++n) bv[bj][n] = bias ? *(const f32x4*)(bias + bcol0 + bj * HALF + 4 * n) : (f32x4){0.f, 0.f, 0.f, 0.f};
#pragma unroll
        for (int ai = 0; ai < 2; ++ai)
#pragma unroll
            for (int m = 0; m < 4; ++m) { bf16_t* rowp = base + (size_t)(row0 + ai * HALF + m * 16) * ldc + col0;
#pragma unroll
                for (int bj = 0; bj < 2; ++bj) { f32x4 v0 = acc[ai][bj][m][0] + bv[bj][0], v1 = acc[ai][bj][m][1] + bv[bj][1];
                    if (ACT == 1) { f32x2 a = gelu_pk((f32x2){v0[0], v0[1]}), b = gelu_pk((f32x2){v0[2], v0[3]}), c = gelu_pk((f32x2){v1[0], v1[1]}), d = gelu_pk((f32x2){v1[2], v1[3]});
                        v0 = (f32x4){a.x, a.y, b.x, b.y}; v1 = (f32x4){c.x, c.y, d.x, d.y}; }
                    v0 = v0 * sc; v1 = v1 * sc; u32x4 w; w.x = cvt_pk_bf16(v0[0], v0[1]); w.y = cvt_pk_bf16(v0[2], v0[3]); w.z = cvt_pk_bf16(v1[0], v1[1]); w.w = cvt_pk_bf16(v1[2], v1[3]);
                    *(u32x4*)(rowp + bj * HALF) = w; } }
    }
};
__device__ __forceinline__ float fast_sigmoid(float x) { return __builtin_amdgcn_rcpf(1.0f + __builtin_amdgcn_exp2f(-1.44269504089f * x)); }
struct EpiSwiGLU {
    static constexpr bool PERM = true, AFTER_DRAIN = false;
    bf16_t* O; int ldc;
    __device__ __forceinline__ void operator()(const f32x4 (&acc)[2][2][4][2], const Unit& u, int wr, int wc, int fr, int fq) const {
        const int row0 = u.pm * BM + wr * 64 + fr, col0 = u.pn * HALF + wc * 32 + 8 * fq;
#pragma unroll
        for (int ai = 0; ai < 2; ++ai)
#pragma unroll
            for (int m = 0; m < 4; ++m) { bf16_t* rowp = O + (size_t)(row0 + ai * HALF + m * 16) * ldc + col0;
                float h[8];
#pragma unroll
                for (int n = 0; n < 2; ++n)
#pragma unroll
                    for (int j = 0; j < 4; ++j) { const float g = acc[ai][0][m][n][j], up = acc[ai][1][m][n][j]; h[4 * n + j] = g * fast_sigmoid(g) * up; }
                u32x4 w; w.x = cvt_pk_bf16(h[0], h[1]); w.y = cvt_pk_bf16(h[2], h[3]); w.z = cvt_pk_bf16(h[4], h[5]); w.w = cvt_pk_bf16(h[6], h[7]);
                *(u32x4*)rowp = w; }
    }
};
struct EpiPleGate {
    static constexpr bool PERM = true, AFTER_DRAIN = false;
    bf16_t* T; int ldc;
    __device__ __forceinline__ void operator()(const f32x4 (&acc)[2][2][4][2], const Unit& u, int wr, int wc, int fr, int fq) const {
        const int row0 = u.pm * BM + wr * 64 + fr, col0 = u.pn * BM + wc * 32 + 8 * fq;
#pragma unroll
        for (int ai = 0; ai < 2; ++ai)
#pragma unroll
            for (int m = 0; m < 4; ++m) { bf16_t* rowp = T + (size_t)(row0 + ai * HALF + m * 16) * ldc + col0;
#pragma unroll
                for (int bj = 0; bj < 2; ++bj) { const u32x4 pw = *(const u32x4*)(rowp + bj * HALF);
                    float o[8];
#pragma unroll
                    for (int n = 0; n < 2; ++n)
#pragma unroll
                        for (int j = 0; j < 4; ++j) { const unsigned word = pw[2 * n + (j >> 1)]; const float pv = __uint_as_float((j & 1) ? (word & 0xffff0000u) : (word << 16));
                            o[4 * n + j] = pv * fast_sigmoid(acc[ai][bj][m][n][j]); }
                    u32x4 w; w.x = cvt_pk_bf16(o[0], o[1]); w.y = cvt_pk_bf16(o[2], o[3]); w.z = cvt_pk_bf16(o[4], o[5]); w.w = cvt_pk_bf16(o[6], o[7]);
                    *(u32x4*)(rowp + bj * HALF) = w; } }
    }
};
template <class Epi, class Sched, bool ALIGN_EPI = false, bool SP2 = false>
__device__ __forceinline__ void gemm_phase(PG8_LAS unsigned char* lds, const Gemm g, const Sched& S, const Epi& E) {
    int tid_o = threadIdx.x; asm volatile("" : "+v"(tid_o));
    const int tid = tid_o, wid = __builtin_amdgcn_readfirstlane(tid >> 6), lane = tid & 63, wr = wid >> 2, wc = wid & 3, fr = lane & 15, fq = lane >> 4;
    const int K = g.K, nt = K / BK;
    unsigned voffA[2], voffB[2];
#pragma unroll
    for (int i = 0; i < 2; ++i) { int R, C; stage_rc(tid * 16 + i * 8192, R, C); const int Rb = Epi::PERM ? ((R & ~31) + perm32(R & 31)) : R;
        voffA[i] = (unsigned)(R * K + C) * 2u; voffB[i] = (unsigned)(Rb * K + C) * 2u; }
    const size_t kstep = (size_t)(BK * 2);
    const size_t hstep = (size_t)HALF * K * 2;
    const size_t tstep = 2 * hstep;
    const unsigned ldsw = (unsigned)wid * 1024u;
    const int aoff = lds_byte(wr * 64 + fr, fq * 8), boff = lds_byte(wc * 32 + fr, fq * 8);
#define PG8_SA(b, h) (((b) * 2 + (h)) * HTB)
#define PG8_SB(b, h) ((4 + (b) * 2 + (h)) * HTB)
#define PG8_STAGE(bufoff, gbase, voff) do { _Pragma("unroll") for (int _i = 0; _i < 2; ++_i) \
        __builtin_amdgcn_global_load_lds((const unsigned*)((const char*)(gbase) + (voff)[_i]), (PG8_LAS unsigned*)(lds + (bufoff) + ldsw + _i * 8192), 16, 0, 0); } while (0)
#define PG8_LDA(dst, b, h) do { _Pragma("unroll") for (int m = 0; m < 4; ++m) _Pragma("unroll") for (int k = 0; k < 2; ++k) dst[m][k] = *(const PG8_LAS bf16x8*)(lds + PG8_SA(b, h) + aoff + m * 2048 + k * 1024); } while (0)
#define PG8_LDB(dst, b, h) do { _Pragma("unroll") for (int n = 0; n < 2; ++n) _Pragma("unroll") for (int k = 0; k < 2; ++k) dst[n][k] = *(const PG8_LAS bf16x8*)(lds + PG8_SB(b, h) + boff + n * 2048 + k * 1024); } while (0)
#define PG8_MMA(ai, bj, At, Bt) do { __builtin_amdgcn_s_setprio(1); _Pragma("unroll") for (int m = 0; m < 4; ++m) _Pragma("unroll") for (int n = 0; n < 2; ++n) _Pragma("unroll") for (int k = 0; k < 2; ++k) \
        acc[ai][bj][m][n] = __builtin_amdgcn_mfma_f32_16x16x32_bf16(Bt[n][k], At[m][k], acc[ai][bj][m][n], 0, 0, 0); __builtin_amdgcn_s_setprio(0); } while (0)
#define PG8_WAIT_V(n) asm volatile("s_waitcnt vmcnt(" #n ")" ::: "memory")
#define PG8_WAIT_L(n) asm volatile("s_waitcnt lgkmcnt(" #n ")" ::: "memory")
#define PG8_BAR __builtin_amdgcn_s_barrier()
#define PG8_SCHED __builtin_amdgcn_sched_barrier(0)
    Unit cur, nxt; int ui = 0;
    if (!S.next(0, cur)) return;
    f32x4 acc[2][2][4][2];
#pragma unroll
    for (int a = 0; a < 2; ++a)
#pragma unroll
        for (int b = 0; b < 2; ++b)
#pragma unroll
            for (int m = 0; m < 4; ++m)
#pragma unroll
                for (int n = 0; n < 2; ++n) acc[a][b][m][n] = (f32x4){0.f, 0.f, 0.f, 0.f};
    bf16x8 At[4][2], B0[2][2], B1[2][2];
    const char* cA = (const char*)g.A + (size_t)cur.pm * tstep; const char* cB = (const char*)g.Bt + (size_t)cur.pn * tstep;
    S.a_ready(cur);
    if constexpr (SP2) {
        PG8_STAGE(PG8_SB(0, 0), cB, voffB); PG8_STAGE(PG8_SB(0, 1), cB + hstep, voffB); PG8_STAGE(PG8_SA(0, 0), cA, voffA); PG8_STAGE(PG8_SA(0, 1), cA + hstep, voffA);
        if (wr == 1) PG8_BAR;
        PG8_WAIT_V(2); PG8_BAR;
        PG8_STAGE(PG8_SB(1, 0), cB + kstep, voffB); PG8_STAGE(PG8_SA(1, 0), cA + kstep, voffA); PG8_STAGE(PG8_SB(1, 1), cB + hstep + kstep, voffB);
        PG8_WAIT_V(6); PG8_BAR;
    } else {
        PG8_STAGE(PG8_SB(0, 0), cB, voffB); PG8_STAGE(PG8_SA(0, 0), cA, voffA); PG8_STAGE(PG8_SB(0, 1), cB + hstep, voffB); PG8_STAGE(PG8_SA(0, 1), cA + hstep, voffA);
        if (wr == 1) PG8_BAR;
        PG8_WAIT_V(4); PG8_BAR;
        PG8_STAGE(PG8_SB(1, 0), cB + kstep, voffB); PG8_STAGE(PG8_SA(1, 0), cA + kstep, voffA); PG8_STAGE(PG8_SB(1, 1), cB + hstep + kstep, voffB);
        PG8_WAIT_V(6); PG8_BAR;
    }
    for (;;) {
        const bool has_next = S.next(ui + 1, nxt);
        const char* nA = has_next ? (const char*)g.A + (size_t)nxt.pm * tstep : cA; const char* nB = has_next ? (const char*)g.Bt + (size_t)nxt.pn * tstep : cB;
        for (int t = 0; t < nt; t += 2) {
            const bool last = (t == nt - 2);
            const char* a1 = cA + (size_t)(t + 1) * kstep;
            const char* a2 = last ? nA : cA + (size_t)(t + 2) * kstep; const char* b2 = last ? nB : cB + (size_t)(t + 2) * kstep;
            const char* a3 = a2 + kstep; const char* b3 = b2 + kstep;
            if (last && has_next) S.a_ready(nxt);
            if constexpr (SP2) {
            PG8_LDB(B0, 0, 0); PG8_LDB(B1, 0, 1); PG8_SCHED; PG8_LDA(At, 0, 0); PG8_STAGE(PG8_SA(1, 1), a1 + hstep, voffA);
            PG8_WAIT_V(8); PG8_WAIT_L(0); PG8_BAR; PG8_MMA(0, 0, At, B0); PG8_MMA(0, 1, At, B1); PG8_BAR; PG8_SCHED;
            PG8_LDA(At, 0, 1); PG8_STAGE(PG8_SB(0, 0), b2, voffB); PG8_STAGE(PG8_SB(0, 1), b2 + hstep, voffB); PG8_STAGE(PG8_SA(0, 0), a2, voffA);
            PG8_WAIT_V(8); PG8_WAIT_L(0); PG8_BAR; PG8_MMA(1, 0, At, B0); PG8_MMA(1, 1, At, B1); PG8_BAR; PG8_SCHED;
            PG8_LDB(B0, 1, 0); PG8_LDB(B1, 1, 1); PG8_SCHED; PG8_LDA(At, 1, 0); PG8_STAGE(PG8_SA(0, 1), a2 + hstep, voffA);
            PG8_WAIT_V(8); PG8_WAIT_L(0); PG8_BAR; PG8_MMA(0, 0, At, B0); PG8_MMA(0, 1, At, B1); PG8_BAR; PG8_SCHED;
            PG8_LDA(At, 1, 1); PG8_STAGE(PG8_SB(1, 0), b3, voffB); PG8_STAGE(PG8_SB(1, 1), b3 + hstep, voffB); PG8_STAGE(PG8_SA(1, 0), a3, voffA);
            PG8_WAIT_V(8); PG8_WAIT_L(0); PG8_BAR; PG8_MMA(1, 0, At, B0); PG8_MMA(1, 1, At, B1); PG8_BAR; PG8_SCHED;
            } else {
            PG8_LDB(B0, 0, 0); PG8_SCHED; PG8_LDA(At, 0, 0); PG8_STAGE(PG8_SA(1, 1), a1 + hstep, voffA);
            PG8_WAIT_L(8); PG8_BAR; PG8_WAIT_L(0); PG8_MMA(0, 0, At, B0); PG8_BAR; PG8_SCHED;
            PG8_LDB(B1, 0, 1); PG8_STAGE(PG8_SB(0, 0), b2, voffB);
            PG8_BAR; PG8_WAIT_L(0); PG8_MMA(0, 1, At, B1); PG8_BAR;
            PG8_LDA(At, 0, 1); PG8_STAGE(PG8_SA(0, 0), a2, voffA);
            PG8_BAR; PG8_WAIT_L(0); PG8_MMA(1, 0, At, B0); PG8_BAR; PG8_SCHED;
            PG8_STAGE(PG8_SB(0, 1), b2 + hstep, voffB);
            PG8_WAIT_V(6); PG8_BAR; PG8_MMA(1, 1, At, B1); PG8_BAR;
            PG8_LDB(B0, 1, 0); PG8_SCHED; PG8_LDA(At, 1, 0); PG8_STAGE(PG8_SA(0, 1), a2 + hstep, voffA);
            PG8_WAIT_L(8); PG8_BAR; PG8_WAIT_L(0); PG8_MMA(0, 0, At, B0); PG8_BAR; PG8_SCHED;
            PG8_LDB(B1, 1, 1); PG8_STAGE(PG8_SB(1, 0), b3, voffB);
            PG8_BAR; PG8_WAIT_L(0); PG8_MMA(0, 1, At, B1); PG8_BAR;
            PG8_LDA(At, 1, 1); PG8_STAGE(PG8_SA(1, 0), a3, voffA);
            PG8_BAR; PG8_WAIT_L(0); PG8_MMA(1, 0, At, B0); PG8_BAR; PG8_SCHED;
            PG8_STAGE(PG8_SB(1, 1), b3 + hstep, voffB);
            PG8_WAIT_V(6); PG8_BAR; PG8_MMA(1, 1, At, B1); PG8_BAR;
            }
        }
        if constexpr (ALIGN_EPI) { if (wr == 0) PG8_BAR; }
        if constexpr (!Epi::AFTER_DRAIN) { E(acc, cur, wr, wc, fr, fq); S.done(cur); }
        if (!has_next) break;
#pragma unroll
        for (int a = 0; a < 2; ++a)
#pragma unroll
            for (int b = 0; b < 2; ++b)
#pragma unroll
                for (int m = 0; m < 4; ++m)
#pragma unroll
                    for (int n = 0; n < 2; ++n) acc[a][b][m][n] = (f32x4){0.f, 0.f, 0.f, 0.f};
        cur = nxt; cA = nA; cB = nB; ++ui;
        if constexpr (ALIGN_EPI) { if (wr == 1) PG8_BAR; }
    }
    PG8_WAIT_V(0);
    if constexpr (!ALIGN_EPI) { if (wr == 0) PG8_BAR; }
    PG8_BAR;
    if constexpr (Epi::AFTER_DRAIN) { E.fused(acc, cur, wr, wc, fr, fq, lds, wid, lane); S.done(cur); }
#undef PG8_SA
#undef PG8_SB
#undef PG8_STAGE
#undef PG8_LDA
#undef PG8_LDB
#undef PG8_MMA
#undef PG8_WAIT_V
#undef PG8_WAIT_L
#undef PG8_BAR
#undef PG8_SCHED
}
}
constexpr int NWAVES = 8;
constexpr int BATCH = 4, T = 4096, D = 4096, M = BATCH * T;
constexpr int NIN = 12288, AW = 2048, FF = 11008, NGU = 2 * FF, PLE = 256, NHEAD = 16, HD = 128;
constexpr int C_Q = 0, C_F = 2048, C_I = 4096, C_G = 6144, C_U = 8192, C_V = 10240;
constexpr float EPS = 1e-6f;

constexpr size_t MiB = 1u << 20;
constexpr size_t WS_CTL = 0, CTL_ZERO_BYTES = 1 * MiB;
constexpr size_t WS_LB = 1 * MiB;
constexpr size_t WS_WIN = 2 * MiB;
constexpr size_t WS_WOUT = 98 * MiB;
constexpr size_t WS_WGU = 130 * MiB;
constexpr size_t WS_WDN = 302 * MiB;
constexpr size_t WS_WPG = 388 * MiB;
constexpr size_t WS_WPLE = 420 * MiB;
constexpr size_t WS_H = 422 * MiB;
constexpr size_t WS_PROJ = 550 * MiB;
constexpr size_t WS_PB = 934 * MiB;
constexpr size_t WS_END = 942 * MiB;
constexpr size_t WS_FF = 2 * MiB;
constexpr int CW_BAR = 4096;

constexpr int RING_BYTES = 131072, LDSCTL_OFF = RING_BYTES, MISC_OFF = LDSCTL_OFF + 320, LDS_BYTES = 147456;

#define GAS __attribute__((address_space(1)))
#define LAS __attribute__((address_space(3)))
typedef unsigned short bf16;
typedef unsigned v4u __attribute__((ext_vector_type(4)));
typedef unsigned v2u __attribute__((ext_vector_type(2)));
typedef float f32x4 __attribute__((ext_vector_type(4)));
typedef float f32x16 __attribute__((ext_vector_type(16)));
typedef short bf16x8 __attribute__((ext_vector_type(8)));
typedef GAS unsigned gu32;
#define LDS_WAIT() asm volatile("s_waitcnt lgkmcnt(0)" ::: "memory")
#define VM_WAIT() asm volatile("s_waitcnt vmcnt(0)" ::: "memory")
__device__ __forceinline__ unsigned f2bf(float f) { unsigned u = __builtin_bit_cast(unsigned, f); return (u + 0x7fffu + ((u >> 16) & 1u)) >> 16; }
__device__ __forceinline__ unsigned pk2(float lo, float hi) { return f2bf(lo) | (f2bf(hi) << 16); }
__device__ __forceinline__ float bf_lo(unsigned w) { return __uint_as_float(w << 16); }
__device__ __forceinline__ float bf_hi(unsigned w) { return __uint_as_float(w & 0xffff0000u); }
__device__ __forceinline__ float bf2f(bf16 b) { return __uint_as_float(((unsigned)b) << 16); }
__device__ __forceinline__ float sigmoidf_(float x) { return 1.0f / (1.0f + __expf(-x)); }
__device__ __forceinline__ float gelu1(float v) {
    const float av = fabsf(v), t = __builtin_amdgcn_rcpf(av * 0.2316418882f + 1.0f);
    float q = t * 0.5307027145f + (-0.7265760135f); q = q * t + 0.7107068705f; q = q * t + (-0.142248368f); q = q * t + 0.127414796f; q = q * t;
    const float e = __builtin_amdgcn_exp2f((v * v) * (-0.72134752044f));
    const float m = v * (q * e);
    return v < 0.f ? m : v - m;
}
__device__ __forceinline__ float wave_sum(float v) {
#pragma unroll
    for (int o = 1; o < 64; o <<= 1) v += __shfl_xor(v, o);
    return v;
}
#define XB_TMO      128
#define XB_XCNT(j)  (256  + 64 * (j))
#define XB_XSUB(j)  (1280 + 64 * (j))
#define XB_XGEN(j)  (2304 + 64 * (j))
#define XB_TOP      3328
#define XB_TOPGEN   3392
#define XCD_BAR_WORDS 3456
#define XB_SPIN_CAP (1u << 18)

__device__ __forceinline__ unsigned xb_ld(unsigned* p)              { return __hip_atomic_load(p, __ATOMIC_RELAXED, __HIP_MEMORY_SCOPE_AGENT); }
__device__ __forceinline__ unsigned xb_add(unsigned* p, unsigned v) { return __hip_atomic_fetch_add(p, v, __ATOMIC_RELAXED, __HIP_MEMORY_SCOPE_AGENT); }
__device__ __forceinline__ unsigned xb_xcc_id() { return (unsigned)__builtin_amdgcn_s_getreg((3 << 11) | 20) & 0xFu; }
#define XB_SPIN(cond, bar) do { unsigned _sp = 0; while (cond) { __builtin_amdgcn_s_sleep(1); \
    if ((++_sp & 255u) == 0u) { if (xb_ld(&(bar)[XB_TMO])) break; if (_sp > XB_SPIN_CAP) { atomicAdd(&(bar)[XB_TMO], 1u); break; } } } } while (0)

struct XcdBarrier {
    unsigned* bar; unsigned x;
    volatile LAS unsigned* st;
};

__device__ __forceinline__ XcdBarrier xcd_barrier_post(unsigned* bar, volatile LAS unsigned* st) {
    XcdBarrier b; b.bar = bar; b.x = xb_xcc_id(); b.st = st;
    if (threadIdx.x == 0) (void)xb_add(&bar[XB_XCNT(b.x)], 1u);
    return b;
}
__device__ __forceinline__ void xcd_barrier_complete(unsigned* bar, unsigned x, unsigned& nloc, unsigned& nx) {
    const unsigned G = gridDim.x * gridDim.y * gridDim.z;
    unsigned sum, cnt, mine, sp = 0u;
    for (;;) {
        sum = 0u; cnt = 0u; mine = 0u;
#pragma unroll
        for (unsigned j = 0; j < 16; ++j) { const unsigned c = xb_ld(&bar[XB_XCNT(j)]); sum += c; cnt += (c > 0u) ? 1u : 0u; mine = (j == x) ? c : mine; }
        if (sum == G) break;
        __builtin_amdgcn_s_sleep(1);
        if ((++sp & 255u) == 0u) { if (xb_ld(&bar[XB_TMO])) break; if (sp > XB_SPIN_CAP) { atomicAdd(&bar[XB_TMO], 1u); break; } }
    }
    nloc = mine > 0u ? mine : 1u; nx = cnt > 0u ? cnt : 1u;
}

__device__ __forceinline__ void xcd_barrier(const XcdBarrier& b) {
    asm volatile("s_waitcnt vmcnt(0)" ::: "memory");
    __syncthreads();
    if (threadIdx.x == 0) {
        unsigned* bar = b.bar;
        __builtin_amdgcn_s_waitcnt(0);
        unsigned nloc = b.st[0], nx = b.st[1];
        if (nloc == 0u) { xcd_barrier_complete(bar, b.x, nloc, nx); b.st[0] = nloc; b.st[1] = nx; }
        const unsigned old = xb_add(&bar[XB_XSUB(b.x)], 1u);
        const unsigned gen = old / nloc;
        if (old + 1u == (gen + 1u) * nloc) {
            __builtin_amdgcn_fence(__ATOMIC_RELEASE, "agent");
            asm volatile("s_waitcnt vmcnt(0)" ::: "memory");
            const unsigned og = xb_add(&bar[XB_TOP], 1u);
            const unsigned tg = og / nx;
            if (og + 1u == (tg + 1u) * nx) xb_add(&bar[XB_TOPGEN], 1u);
            else XB_SPIN(xb_ld(&bar[XB_TOPGEN]) == tg, bar);
            __builtin_amdgcn_fence(__ATOMIC_ACQUIRE, "agent");
            xb_add(&bar[XB_XGEN(b.x)], 1u);
            asm volatile("s_waitcnt vmcnt(0)" ::: "memory");
        } else {
            XB_SPIN(xb_ld(&bar[XB_XGEN(b.x)]) == gen, bar);
            __builtin_amdgcn_fence(__ATOMIC_ACQUIRE, "agent");
            asm volatile("s_waitcnt vmcnt(0)" ::: "memory");
        }
    }
    __syncthreads();
}
__device__ __forceinline__ void p0_transpose_item(const float* W, int K, int N, bf16* WT, int k0, int n0, int drow0, LAS float* scr, int lane) {
    float v[32];
#pragma unroll
    for (int i = 0; i < 32; ++i) { const int kk = 2 * i + (lane >> 5); v[i] = W[(size_t)(k0 + kk) * N + n0 + (lane & 31)]; }
#pragma unroll
    for (int i = 0; i < 32; ++i) { const int kk = 2 * i + (lane >> 5); scr[kk * 33 + (lane & 31)] = v[i]; }
    LDS_WAIT(); asm volatile("" ::: "memory");
    const int c = lane & 7;
#pragma unroll
    for (int j = 0; j < 4; ++j) { const int n = (lane >> 3) + 8 * j; const LAS float* s = scr + (8 * c) * 33 + n;
        v4u o; o.x = pk2(s[0 * 33], s[1 * 33]); o.y = pk2(s[2 * 33], s[3 * 33]); o.z = pk2(s[4 * 33], s[5 * 33]); o.w = pk2(s[6 * 33], s[7 * 33]);
        *(GAS v4u*)(WT + (size_t)(drow0 + n) * K + k0 + 8 * c) = o; }
    LDS_WAIT(); asm volatile("" ::: "memory");
}
__device__ __forceinline__ void load_row_f32(const float* row, int lane, f32x4 (&v)[16]) {
    const GAS f32x4* p = (const GAS f32x4*)row + lane;
#pragma unroll
    for (int j = 0; j < 16; ++j) v[j] = p[64 * j];
}
__device__ __forceinline__ void load_row_bf16(const bf16* row, int lane, f32x4 (&v)[16]) {
    const GAS v2u* p = (const GAS v2u*)row + lane;
#pragma unroll
    for (int j = 0; j < 16; ++j) { const v2u w = p[64 * j]; v[j] = (f32x4){bf_lo(w.x), bf_hi(w.x), bf_lo(w.y), bf_hi(w.y)}; }
}
__device__ __forceinline__ float row_sumsq(const f32x4 (&v)[16]) {
    float s = 0.f;
#pragma unroll
    for (int j = 0; j < 16; ++j) s += (v[j].x * v[j].x + v[j].y * v[j].y) + (v[j].z * v[j].z + v[j].w * v[j].w);
    return wave_sum(s);
}
__device__ __forceinline__ void store_row_bf16(bf16* row, int lane, const f32x4 (&v)[16]) {
    GAS v2u* p = (GAS v2u*)row + lane;
#pragma unroll
    for (int j = 0; j < 16; ++j) { v2u w; w.x = pk2(v[j].x, v[j].y); w.y = pk2(v[j].z, v[j].w); p[64 * j] = w; }
}
__device__ __forceinline__ void store_row_f32(float* row, int lane, const f32x4 (&v)[16]) {
    GAS f32x4* p = (GAS f32x4*)row + lane;
#pragma unroll
    for (int j = 0; j < 16; ++j) p[64 * j] = v[j];
}
template <int MODE> __device__ __forceinline__ void row_pass(const bf16* Ab, const float* Xin, float* Xout, bf16* Hb, const float* w1, const float* w2, int gw, int ngw, int lane) {
    for (int m = gw; m < M; m += ngw) {
        asm volatile("" ::: "memory");
        v2u ap[16]; f32x4 x[16];
        { const GAS v2u* p = (const GAS v2u*)(Ab + (size_t)m * D) + lane;
#pragma unroll
          for (int j = 0; j < 16; ++j) ap[j] = p[64 * j]; }
        load_row_f32(Xin + (size_t)m * D, lane, x);
        float s = 0.f;
#pragma unroll
        for (int j = 0; j < 16; ++j) { const float a0 = bf_lo(ap[j].x), a1 = bf_hi(ap[j].x), a2 = bf_lo(ap[j].y), a3 = bf_hi(ap[j].y); s += (a0 * a0 + a1 * a1) + (a2 * a2 + a3 * a3); }
        const float r1 = rsqrtf(wave_sum(s) * (1.0f / D) + EPS);
        asm volatile("" ::: "memory");
        const GAS f32x4* wp1 = (const GAS f32x4*)w1 + lane;
#pragma unroll
        for (int j = 0; j < 16; ++j) { const f32x4 w = wp1[64 * j]; const f32x4 a = (f32x4){bf_lo(ap[j].x), bf_hi(ap[j].x), bf_lo(ap[j].y), bf_hi(ap[j].y)}; x[j] = x[j] + a * r1 * w; }
        store_row_f32(Xout + (size_t)m * D, lane, x);
        if (MODE == 0) {
            const float r2 = rsqrtf(row_sumsq(x) * (1.0f / D) + EPS);
            asm volatile("" ::: "memory");
            const GAS f32x4* wp2 = (const GAS f32x4*)w2 + lane;
#pragma unroll
            for (int j = 0; j < 16; ++j) x[j] = x[j] * r2 * wp2[64 * j];
            store_row_bf16(Hb + (size_t)m * D, lane, x);
        } else if (MODE == 1) {
            store_row_bf16(Hb + (size_t)m * D, lane, x);
        }
    }
}

#define MFMA32(a, b, c) __builtin_amdgcn_mfma_f32_32x32x16_bf16((a), (b), (c), 0, 0, 0)
__device__ __forceinline__ int crow(int reg, int h) { return (reg & 3) + 8 * (reg >> 2) + 4 * h; }
constexpr int QH_OFF = 0, KH_OFF = 17408, KHT_OFF = 34816, VT_OFF = 53248, AM_OFF = 71680, ST_OFF = 80896, SEG_OFF = 115712, OL_OFF = 0;
constexpr int LDQ = 272  , LDT = 144  , LDO = 528  ;
static_assert(SEG_OFF + 2048 <= RING_BYTES && 64 * LDO <= KHT_OFF, "hgrn2 LDS map");

__device__ __forceinline__ void hgrn2_unit(LAS unsigned char* L, const bf16* proj, const float* lbv, const float* anw, bf16* mixin, int b, int h, int tid) {
    const int lane = tid & 63, wave = __builtin_amdgcn_readfirstlane(tid >> 6), r32 = lane & 31, hh = lane >> 5;
    const int k = tid & 127, seg = tid >> 7;
    const float lb = lbv[HD * h + k], oml = 1.0f - lb;
    for (int e = tid; e < 1024; e += 512) { const int t = e >> 5, s = 32 + (e & 31); *(LAS bf16*)(L + AM_OFF + t * LDT + s * 2) = (bf16)0; }
    f32x16 S0, S1;
#pragma unroll
    for (int i = 0; i < 16; ++i) { S0[i] = 0.f; S1[i] = 0.f; }
    const int svi = wave >> 1, ski = 2 * (wave & 1);
    const int oti = wave >> 2, ovi = wave & 3;
    const LAS float* sg = (const LAS float*)(L + SEG_OFF);
    for (int n = 0; n < T / 64; ++n) {
        const size_t row0 = (size_t)b * T + 64 * n;
        const bf16* pr = proj + (row0 + 16 * seg) * NIN + HD * h + k;
        float qv[16], bl[16], kf[16]; unsigned iv[16];
#pragma unroll
        for (int i = 0; i < 16; ++i) { qv[i] = bf2f(pr[(size_t)i * NIN + C_Q]); bl[i] = bf2f(pr[(size_t)i * NIN + C_F]); iv[i] = pr[(size_t)i * NIN + C_I]; }
        float cum = 0.f;
#pragma unroll
        for (int i = 0; i < 16; ++i) { const float f = lb + oml * sigmoidf_(bl[i]); cum += __logf(fmaxf(f, 1e-30f)); bl[i] = cum; kf[i] = 1.0f - f; qv[i] = qv[i] * sigmoidf_(qv[i]); }
        *(LAS float*)(L + SEG_OFF + (seg * 128 + k) * 4) = cum;
        { v4u w0, w1; w0.x = iv[0] | (iv[1] << 16); w0.y = iv[2] | (iv[3] << 16); w0.z = iv[4] | (iv[5] << 16); w0.w = iv[6] | (iv[7] << 16);
          w1.x = iv[8] | (iv[9] << 16); w1.y = iv[10] | (iv[11] << 16); w1.z = iv[12] | (iv[13] << 16); w1.w = iv[14] | (iv[15] << 16);
          LAS v4u* vt = (LAS v4u*)(L + VT_OFF + k * LDT + 32 * seg); vt[0] = w0; vt[1] = w1; }
        __syncthreads();
        {
            const float t0 = sg[k], t1 = sg[128 + k], t2 = sg[256 + k];
            const float off = (seg > 0 ? t0 : 0.f) + (seg > 1 ? t1 : 0.f) + (seg > 2 ? t2 : 0.f);
            const float r = t0 + t1;
            unsigned kt[16];
#pragma unroll
            for (int i = 0; i < 16; ++i) { const float bt = off + bl[i];
                const float qh = qv[i] * __expf(fminf(bt - r, 80.f)), kh = kf[i] * __expf(fminf(r - bt, 80.f));
                const unsigned kb = f2bf(kh); kt[i] = kb;
                *(LAS bf16*)(L + QH_OFF + (16 * seg + i) * LDQ + k * 2) = (bf16)f2bf(qh);
                *(LAS bf16*)(L + KH_OFF + (16 * seg + i) * LDQ + k * 2) = (bf16)kb; }
            v4u w0, w1; w0.x = kt[0] | (kt[1] << 16); w0.y = kt[2] | (kt[3] << 16); w0.z = kt[4] | (kt[5] << 16); w0.w = kt[6] | (kt[7] << 16);
            w1.x = kt[8] | (kt[9] << 16); w1.y = kt[10] | (kt[11] << 16); w1.z = kt[12] | (kt[13] << 16); w1.w = kt[14] | (kt[15] << 16);
            LAS v4u* kp = (LAS v4u*)(L + KHT_OFF + k * LDT + 32 * seg); kp[0] = w0; kp[1] = w1;
        }
        const int kk0 = 32 * ski + r32, kk1 = kk0 + 32;
        const float er0 = __expf(sg[kk0] + sg[128 + kk0]), er1 = __expf(sg[kk1] + sg[128 + kk1]);
        const float ee0 = __expf(sg[256 + kk0] + sg[384 + kk0]), ee1 = __expf(sg[256 + kk1] + sg[384 + kk1]);
#pragma unroll
        for (int i = 0; i < 16; ++i) { S0[i] *= er0; S1[i] *= er1; const int v = 32 * svi + crow(i, hh);
            *(LAS bf16*)(L + ST_OFF + v * LDQ + kk0 * 2) = (bf16)f2bf(S0[i]); *(LAS bf16*)(L + ST_OFF + v * LDQ + kk1 * 2) = (bf16)f2bf(S1[i]); }
        __syncthreads();
        f32x16 O;
#pragma unroll
        for (int i = 0; i < 16; ++i) O[i] = 0.f;
#pragma unroll
        for (int ks = 0; ks < 8; ++ks) { const bf16x8 a = *(const LAS bf16x8*)(L + QH_OFF + (32 * oti + r32) * LDQ + 32 * ks + 16 * hh);
            const bf16x8 bb = *(const LAS bf16x8*)(L + ST_OFF + (32 * ovi + r32) * LDQ + 32 * ks + 16 * hh); O = MFMA32(a, bb, O); }
#pragma unroll
        for (int ss = 0; ss < 4; ++ss) { const bf16x8 a = *(const LAS bf16x8*)(L + VT_OFF + (32 * svi + r32) * LDT + 32 * ss + 16 * hh);
            const bf16x8 b0 = *(const LAS bf16x8*)(L + KHT_OFF + (32 * ski + r32) * LDT + 32 * ss + 16 * hh);
            const bf16x8 b1 = *(const LAS bf16x8*)(L + KHT_OFF + (32 * ski + 32 + r32) * LDT + 32 * ss + 16 * hh);
            S0 = MFMA32(a, b0, S0); S1 = MFMA32(a, b1, S1); }
#pragma unroll
        for (int i = 0; i < 16; ++i) { S0[i] *= ee0; S1[i] *= ee1; }
        if (wave < 3) {
            const int ti = wave ? 1 : 0, si = (wave == 2) ? 1 : 0;
            f32x16 Sc;
#pragma unroll
            for (int i = 0; i < 16; ++i) Sc[i] = 0.f;
#pragma unroll
            for (int ks = 0; ks < 8; ++ks) { const bf16x8 a = *(const LAS bf16x8*)(L + QH_OFF + (32 * ti + r32) * LDQ + 32 * ks + 16 * hh);
                const bf16x8 bb = *(const LAS bf16x8*)(L + KH_OFF + (32 * si + r32) * LDQ + 32 * ks + 16 * hh); Sc = MFMA32(a, bb, Sc); }
#pragma unroll
            for (int i = 0; i < 16; ++i) { const int t = 32 * ti + crow(i, hh), s = 32 * si + r32; const float val = (s <= t) ? Sc[i] : 0.f;
                *(LAS bf16*)(L + AM_OFF + t * LDT + s * 2) = (bf16)f2bf(val); }
        }
        __syncthreads();
#pragma unroll
        for (int ss = 0; ss < 4; ++ss) { const bf16x8 a = *(const LAS bf16x8*)(L + AM_OFF + (32 * oti + r32) * LDT + 32 * ss + 16 * hh);
            const bf16x8 bb = *(const LAS bf16x8*)(L + VT_OFF + (32 * ovi + r32) * LDT + 32 * ss + 16 * hh); O = MFMA32(a, bb, O); }
#pragma unroll
        for (int i = 0; i < 16; ++i) { const int t = 32 * oti + crow(i, hh), v = 32 * ovi + r32; *(LAS float*)(L + OL_OFF + t * LDO + v * 4) = O[i]; }
        __syncthreads();
        {
            const int t = tid >> 3, c = tid & 7;
            const LAS f32x4* op = (const LAS f32x4*)(L + OL_OFF + t * LDO + c * 64);
            f32x4 o4[4]; float ssq = 0.f;
#pragma unroll
            for (int q = 0; q < 4; ++q) { o4[q] = op[q]; ssq += (o4[q].x * o4[q].x + o4[q].y * o4[q].y) + (o4[q].z * o4[q].z + o4[q].w * o4[q].w); }
            ssq += __shfl_xor(ssq, 1); ssq += __shfl_xor(ssq, 2); ssq += __shfl_xor(ssq, 4);
            const float rstd = rsqrtf(ssq * (1.0f / HD) + EPS);
            const GAS v4u* gp = (const GAS v4u*)(proj + (row0 + t) * NIN + C_G + HD * h + 16 * c);
            const GAS f32x4* wp = (const GAS f32x4*)(anw + HD * h + 16 * c);
            GAS v4u* dst = (GAS v4u*)(mixin + (row0 + t) * D + HD * h + 16 * c);
#pragma unroll
            for (int half = 0; half < 2; ++half) { const v4u g = gp[half]; const f32x4 wa = wp[2 * half], wb = wp[2 * half + 1]; const f32x4 oa = o4[2 * half], ob = o4[2 * half + 1];
                float gv[8] = {bf_lo(g.x), bf_hi(g.x), bf_lo(g.y), bf_hi(g.y), bf_lo(g.z), bf_hi(g.z), bf_lo(g.w), bf_hi(g.w)};
                float ov[8] = {oa.x * wa.x, oa.y * wa.y, oa.z * wa.z, oa.w * wa.w, ob.x * wb.x, ob.y * wb.y, ob.z * wb.z, ob.w * wb.w};
#pragma unroll
                for (int j = 0; j < 8; ++j) ov[j] = ov[j] * rstd * gv[j] * sigmoidf_(gv[j]);
                v4u w; w.x = pk2(ov[0], ov[1]); w.y = pk2(ov[2], ov[3]); w.z = pk2(ov[4], ov[5]); w.w = pk2(ov[6], ov[7]); dst[half] = w; }
        }
        __syncthreads();
    }
}

constexpr int GA_OFF = 0, GV_OFF = 34816, GS_OFF = 69632;
__device__ __forceinline__ void gmlp_unit(LAS unsigned char* L, const bf16* proj, const float* lnw, const float* lnb, const float* wsp, const float* bsp, bf16* mixin, int b, int n, int tid) {
    const int lane = tid & 63, wave = __builtin_amdgcn_readfirstlane(tid >> 6), r32 = lane & 31, hh = lane >> 5;
    const size_t row0 = (size_t)b * T + 128 * n;
    LAS float* stat = (LAS float*)(L + GS_OFF);
    for (int rr = 0; rr < 16; ++rr) { const int row = 16 * wave + rr;
        const GAS v4u* vp = (const GAS v4u*)(proj + (row0 + row) * NIN + C_V) + lane;
        float x[32]; float s = 0.f;
#pragma unroll
        for (int j = 0; j < 4; ++j) { const v4u w = vp[64 * j];
            x[8 * j + 0] = gelu1(bf_lo(w.x)); x[8 * j + 1] = gelu1(bf_hi(w.x)); x[8 * j + 2] = gelu1(bf_lo(w.y)); x[8 * j + 3] = gelu1(bf_hi(w.y));
            x[8 * j + 4] = gelu1(bf_lo(w.z)); x[8 * j + 5] = gelu1(bf_hi(w.z)); x[8 * j + 6] = gelu1(bf_lo(w.w)); x[8 * j + 7] = gelu1(bf_hi(w.w)); }
#pragma unroll
        for (int j = 0; j < 32; ++j) s += x[j];
        const float mean = wave_sum(s) * (1.0f / AW); float d2 = 0.f;
#pragma unroll
        for (int j = 0; j < 32; ++j) { const float d = x[j] - mean; d2 += d * d; }
        const float rstd = rsqrtf(wave_sum(d2) * (1.0f / AW) + EPS);
        if (lane == 0) { stat[2 * row] = mean; stat[2 * row + 1] = rstd; } }
    __syncthreads();
    const int ti = wave >> 1, di0 = 2 * (wave & 1);
    for (int g = 0; g < 16; ++g) {
        {
            const int t = tid >> 2, sq = tid & 3;
            const GAS f32x4* wp = (const GAS f32x4*)(wsp + ((size_t)g * 128 + t) * 128 + 32 * sq);
            LAS v4u* dst = (LAS v4u*)(L + GA_OFF + t * LDQ + 64 * sq);
#pragma unroll
            for (int q2 = 0; q2 < 4; ++q2) { const f32x4 a = wp[2 * q2], c = wp[2 * q2 + 1]; const int s0 = 32 * sq + 8 * q2;
                v4u w; w.x = pk2(s0 + 0 <= t ? a.x : 0.f, s0 + 1 <= t ? a.y : 0.f); w.y = pk2(s0 + 2 <= t ? a.z : 0.f, s0 + 3 <= t ? a.w : 0.f);
                w.z = pk2(s0 + 4 <= t ? c.x : 0.f, s0 + 5 <= t ? c.y : 0.f); w.w = pk2(s0 + 6 <= t ? c.z : 0.f, s0 + 7 <= t ? c.w : 0.f); dst[q2] = w; }
        }
        {
            const int d = tid & 127, seg = tid >> 7, c = 128 * g + d; const float lw = lnw[c], lbb = lnb[c];
            const bf16* vp = proj + (row0 + 32 * seg) * NIN + C_V + c;
            unsigned y[32];
#pragma unroll
            for (int i = 0; i < 32; ++i) { const float raw = bf2f(vp[(size_t)i * NIN]); const int s = 32 * seg + i;
                y[i] = f2bf((gelu1(raw) - stat[2 * s]) * stat[2 * s + 1] * lw + lbb); }
            LAS v4u* dst = (LAS v4u*)(L + GV_OFF + d * LDQ + 64 * seg);
#pragma unroll
            for (int q = 0; q < 4; ++q) { v4u w; w.x = y[8 * q] | (y[8 * q + 1] << 16); w.y = y[8 * q + 2] | (y[8 * q + 3] << 16); w.z = y[8 * q + 4] | (y[8 * q + 5] << 16); w.w = y[8 * q + 6] | (y[8 * q + 7] << 16); dst[q] = w; }
        }
        __syncthreads();
        f32x16 Z0, Z1;
#pragma unroll
        for (int i = 0; i < 16; ++i) { Z0[i] = 0.f; Z1[i] = 0.f; }
        for (int ss = 0; ss < 2 * ti + 2; ++ss) { const bf16x8 a = *(const LAS bf16x8*)(L + GA_OFF + (32 * ti + r32) * LDQ + 32 * ss + 16 * hh);
            const bf16x8 b0 = *(const LAS bf16x8*)(L + GV_OFF + (32 * di0 + r32) * LDQ + 32 * ss + 16 * hh);
            const bf16x8 b1 = *(const LAS bf16x8*)(L + GV_OFF + (32 * di0 + 32 + r32) * LDQ + 32 * ss + 16 * hh);
            Z0 = MFMA32(a, b0, Z0); Z1 = MFMA32(a, b1, Z1); }
#pragma unroll
        for (int i = 0; i < 16; ++i) { const int t = 32 * ti + crow(i, hh); const float bs = bsp[g * 128 + t];
            const bf16* up = proj + (row0 + t) * NIN + C_U + 128 * g + 32 * di0 + r32; bf16* op = mixin + (row0 + t) * D + AW + 128 * g + 32 * di0 + r32;
            op[0] = (bf16)f2bf(gelu1(bf2f(up[0])) * (Z0[i] + bs)); op[32] = (bf16)f2bf(gelu1(bf2f(up[32])) * (Z1[i] + bs)); }
        __syncthreads();
    }
}
struct Args { const float* in[20]; float* out; unsigned char* ws; };
__global__ void __launch_bounds__(NWAVES * 64, 2) hymba_fwd(Args args) {
    extern __shared__ __attribute__((aligned(16))) unsigned char lds[];
    LAS unsigned char* L = (LAS unsigned char*)lds;
    volatile LAS unsigned* MISC = (volatile LAS unsigned*)(L + MISC_OFF);
#define FRESH_IDS() int tid = threadIdx.x; asm volatile("" : "+v"(tid)); const int lane = tid & 63, wave = __builtin_amdgcn_readfirstlane(tid >> 6), gw = blockIdx.x * NWAVES + wave; (void)lane; (void)gw
    const int G = gridDim.x, NGW = G * NWAVES;
    unsigned char* ws = args.ws;
    gu32* ctl = (gu32*)(ws + WS_CTL);
    const float* x = args.in[0]; const float* p = args.in[1]; const float* pre_mix_w = args.in[2]; const float* w_in = args.in[3]; const float* lb_param = args.in[4];
    const float* a_norm_w = args.in[5]; const float* ln_w = args.in[6]; const float* ln_b = args.in[7]; const float* w_sp = args.in[8]; const float* b_sp = args.in[9];
    const float* w_out = args.in[10]; const float* post_mix_w = args.in[11]; const float* pre_ffn_w = args.in[12]; const float* w_gate = args.in[13]; const float* w_up = args.in[14];
    const float* w_down = args.in[15]; const float* post_ffn_w = args.in[16]; const float* w_ple = args.in[17]; const float* w_pg = args.in[18]; const float* post_ple_w = args.in[19];
    float* out = args.out;
    float* lbv = (float*)(ws + WS_LB);
    bf16* Win_t = (bf16*)(ws + WS_WIN); bf16* Wout_t = (bf16*)(ws + WS_WOUT); bf16* Wgu_t = (bf16*)(ws + WS_WGU); bf16* Wdn_t = (bf16*)(ws + WS_WDN);
    bf16* Wpg_t = (bf16*)(ws + WS_WPG); bf16* Wple_t = (bf16*)(ws + WS_WPLE);
    bf16* HB = (bf16*)(ws + WS_H); bf16* PROJ = (bf16*)(ws + WS_PROJ); bf16* PB = (bf16*)(ws + WS_PB); bf16* FFB = (bf16*)(ws + WS_FF);

    for (int u = threadIdx.x; u < (LDS_BYTES - LDSCTL_OFF) / 4; u += NWAVES * 64) ((LAS unsigned*)(L + LDSCTL_OFF))[u] = 0u;
    __syncthreads();
    XcdBarrier bar = xcd_barrier_post((unsigned*)(ctl + CW_BAR), MISC + 8);

    {
        FRESH_IDS();
        LAS float* scr = (LAS float*)(L + wave * 16384);
        constexpr int I_IN = (D / 64) * (NIN / 32), I_OUT = (D / 64) * (D / 32), I_G = (D / 64) * (FF / 32), I_DN = (FF / 64) * (D / 32), I_PG = I_OUT, I_PLE = (PLE / 64) * (D / 32);
        constexpr int NITEMS = I_IN + I_OUT + 2 * I_G + I_DN + I_PG + I_PLE;
        for (int it = gw; it < NITEMS; it += NGW) {
            int r = it;
            if (r < I_IN) { const int nb = NIN / 32; p0_transpose_item(w_in, D, NIN, Win_t, 64 * (r / nb), 32 * (r % nb), 32 * (r % nb), scr, lane); continue; } r -= I_IN;
            if (r < I_OUT) { const int nb = D / 32; p0_transpose_item(w_out, D, D, Wout_t, 64 * (r / nb), 32 * (r % nb), 32 * (r % nb), scr, lane); continue; } r -= I_OUT;
            if (r < I_G) { const int nb = FF / 32, n0 = 32 * (r % nb); p0_transpose_item(w_gate, D, FF, Wgu_t, 64 * (r / nb), n0, 256 * (n0 >> 7) + (n0 & 127), scr, lane); continue; } r -= I_G;
            if (r < I_G) { const int nb = FF / 32, n0 = 32 * (r % nb); p0_transpose_item(w_up, D, FF, Wgu_t, 64 * (r / nb), n0, 256 * (n0 >> 7) + 128 + (n0 & 127), scr, lane); continue; } r -= I_G;
            if (r < I_DN) { const int nb = D / 32; p0_transpose_item(w_down, FF, D, Wdn_t, 64 * (r / nb), 32 * (r % nb), 32 * (r % nb), scr, lane); continue; } r -= I_DN;
            if (r < I_PG) { const int nb = D / 32; p0_transpose_item(w_pg, D, D, Wpg_t, 64 * (r / nb), 32 * (r % nb), 32 * (r % nb), scr, lane); continue; } r -= I_PG;
            { const int nb = D / 32; p0_transpose_item(w_ple, PLE, D, Wple_t, 64 * (r / nb), 32 * (r % nb), 32 * (r % nb), scr, lane); }
        }
        for (int m = gw; m < M; m += NGW) {
            asm volatile("" ::: "memory");
            f32x4 v[16]; load_row_f32(x + (size_t)m * D, lane, v);
            const float r = rsqrtf(row_sumsq(v) * (1.0f / D) + EPS);
            const GAS f32x4* wp = (const GAS f32x4*)pre_mix_w + lane;
#pragma unroll
            for (int j = 0; j < 16; ++j) v[j] = v[j] * r * wp[64 * j];
            store_row_bf16(HB + (size_t)m * D, lane, v);
        }
        for (int m = gw; m < M; m += NGW) {
            const f32x4 v = ((const GAS f32x4*)(p + (size_t)m * PLE))[lane]; v2u w; w.x = pk2(v.x, v.y); w.y = pk2(v.z, v.w); ((GAS v2u*)(PB + (size_t)m * PLE))[lane] = w;
        }
        if (blockIdx.x == 0) for (int k = tid; k < AW; k += NWAVES * 64) lbv[k] = 1.0f / (1.0f + __expf(lb_param[AW + k] - lb_param[k]));
    }
    xcd_barrier(bar);

    {
        pg8::Gemm g{HB, Win_t, M, NIN, D}; pg8::StaticOrder S; S.init(M, NIN, G, (int)blockIdx.x);
        pg8::EpiBf16<0> E{PROJ, NIN, nullptr, 0, 0, 1.f};
        pg8::gemm_phase<pg8::EpiBf16<0>, pg8::StaticOrder, true, true>(L, g, S, E);
    }
    xcd_barrier(bar);

    for (int u = blockIdx.x; u < 192; u += G) {
        FRESH_IDS();
        if (u < 64) hgrn2_unit(L, PROJ, lbv, a_norm_w, HB, u >> 4, u & 15, tid);
        else gmlp_unit(L, PROJ, ln_w, ln_b, w_sp, b_sp, HB, (u - 64) >> 5, (u - 64) & 31, tid);
    }
    xcd_barrier(bar);

    {
        pg8::Gemm g{HB, Wout_t, M, D, D}; pg8::StaticOrder S; S.init(M, D, G, (int)blockIdx.x);
        pg8::EpiBf16<0> E{PROJ, D, nullptr, 0, 0, 1.f};
        pg8::gemm_phase<pg8::EpiBf16<0>, pg8::StaticOrder, true, true>(L, g, S, E);
    }
    xcd_barrier(bar);
    { FRESH_IDS(); row_pass<0>(PROJ, x, out, HB, post_mix_w, pre_ffn_w, gw, NGW, lane); }
    xcd_barrier(bar);

    {
        pg8::Gemm g{HB, Wgu_t, M, NGU, D}; pg8::StaticOrder S; S.init(M, NGU, G, (int)blockIdx.x);
        pg8::EpiSwiGLU E{PROJ, FF};
        pg8::gemm_phase<pg8::EpiSwiGLU, pg8::StaticOrder, true, true>(L, g, S, E);
    }
    xcd_barrier(bar);

    {
        pg8::Gemm g{PROJ, Wdn_t, M, D, FF}; pg8::StaticOrder S; S.init(M, D, G, (int)blockIdx.x);
        pg8::EpiBf16<0> E{FFB, D, nullptr, 0, 0, 1.f};
        pg8::gemm_phase<pg8::EpiBf16<0>, pg8::StaticOrder, true, true>(L, g, S, E);
    }
    xcd_barrier(bar);
    { FRESH_IDS(); row_pass<1>(FFB, out, out, HB, post_ffn_w, nullptr, gw, NGW, lane); }
    xcd_barrier(bar);

    {
        pg8::Gemm g{PB, Wple_t, M, D, PLE}; pg8::StaticOrder S; S.init(M, D, G, (int)blockIdx.x);
        pg8::EpiBf16<0> E{PROJ, D, nullptr, 0, 0, 1.f};
        pg8::gemm_phase<pg8::EpiBf16<0>, pg8::StaticOrder, true, true>(L, g, S, E);
    }
    VM_WAIT(); __syncthreads();
    {
        pg8::Gemm g{HB, Wpg_t, M, D, D}; pg8::StaticOrder S; S.init(M, D, G, (int)blockIdx.x);
        pg8::EpiPleGate E{PROJ, D};
        pg8::gemm_phase<pg8::EpiPleGate, pg8::StaticOrder, true, true>(L, g, S, E);
    }
    xcd_barrier(bar);
    { FRESH_IDS(); row_pass<2>(PROJ, out, out, nullptr, post_ple_w, nullptr, gw, NGW, lane); }
}

extern "C" void kernel_launch(void* const* d_in, const int* in_sizes, int n_in, void* d_out, int out_size, void* d_ws, size_t ws_size, hipStream_t stream) {
    static int grid = 0;
    if (grid == 0) {
        if (n_in != 20 || in_sizes[0] != M * D || out_size != M * D || ws_size < WS_END) { fprintf(stderr, "kernel_launch: unexpected shapes (n_in %d, in0 %d, out %d, ws %zu); nothing launched\n", n_in, n_in > 0 ? in_sizes[0] : -1, out_size, ws_size); grid = -1; return; }
        int dev = 0, cus = 0, per_cu = 0;
        if (hipGetDevice(&dev) != hipSuccess || hipDeviceGetAttribute(&cus, hipDeviceAttributeMultiprocessorCount, dev) != hipSuccess) { grid = -1; return; }
        if (hipFuncSetAttribute((const void*)hymba_fwd, hipFuncAttributeMaxDynamicSharedMemorySize, LDS_BYTES) != hipSuccess) { fprintf(stderr, "kernel_launch: hipFuncSetAttribute failed\n"); grid = -1; return; }
        if (hipOccupancyMaxActiveBlocksPerMultiprocessor(&per_cu, (const void*)hymba_fwd, NWAVES * 64, LDS_BYTES) != hipSuccess || per_cu < 1) { fprintf(stderr, "kernel_launch: occupancy query reports %d blocks per CU\n", per_cu); }
        (void)hipGetLastError();
        grid = cus;
    }
    if (grid < 0) return;
    if (hipMemsetAsync((char*)d_ws + WS_CTL, 0, CTL_ZERO_BYTES, stream) != hipSuccess) return;
    Args a{};
    for (int i = 0; i < 20; ++i) a.in[i] = (const float*)d_in[i];
    a.out = (float*)d_out; a.ws = (unsigned char*)d_ws;
    hipLaunchKernelGGL(hymba_fwd, dim3(grid), dim3(NWAVES * 64), LDS_BYTES, stream, a);
}
```

```cpp
#include <hip/hip_runtime.h>
#include <cstdio>
#include <cstdint>
namespace pg8 {
#define PG8_LAS __attribute__((address_space(3)))
typedef unsigned short bf16_t;
typedef short bf16x8 __attribute__((ext_vector_type(8)));
typedef float f32x4 __attribute__((ext_vector_type(4)));
typedef unsigned u32x4 __attribute__((ext_vector_type(4)));
constexpr int BM = 256, BK = 64, HALF = 128, HTB = HALF * BK * 2  , STAGE_BYTES = 8 * HTB, NXCD = 8, WGM = 8;

__host__ __device__ __forceinline__ int lds_byte(int r, int c) { const int st = (r >> 4) * 2 + (c >> 5), rr = r & 15, cc = c & 31, ob = rr * 64 + cc * 2; return st * 1024 + (ob ^ (((ob >> 9) & 1) << 5)); }
__host__ __device__ __forceinline__ void stage_rc(int b, int& R, int& C) { const int st = b / 1024, sb = b % 1024, swz = sb ^ (((sb >> 9) & 1) << 5); R = (st >> 1) * 16 + swz / 64; C = (st & 1) * 32 + (swz % 64) / 2; }
__host__ __device__ __forceinline__ int perm32(int rho) { const int n = rho >> 4, i = rho & 15; return 8 * (i >> 2) + 4 * n + (i & 3); }

struct Unit { int pm, pn; };
struct Gemm { const bf16_t* A; const bf16_t* Bt; int M, N, K; };

struct StaticOrder {
    int nM, nN, nwg, G, c;
    __host__ __device__ void init(int M, int N, int G_, int c_) { nM = M / BM; nN = N / BM; nwg = nM * nN; G = G_; c = c_; }
    __host__ __device__ bool next(int i, Unit& u) const {
        const long L = (long)i * G + c; if (L >= nwg) return false;
        int wgid = (int)L; { const int q = nwg / NXCD, r = nwg % NXCD, xcd = wgid % NXCD, off = wgid / NXCD; wgid = (xcd < r ? xcd * (q + 1) : r * (q + 1) + (xcd - r) * q) + off; }
        const int nig = WGM * nN, gid = wgid / nig, fm = gid * WGM, gsz = (nM - fm) < WGM ? (nM - fm) : WGM;
        u.pm = fm + ((wgid % nig) % gsz); u.pn = (wgid % nig) / gsz; return true;
    }
    __device__ __forceinline__ void a_ready(const Unit&) const {}
    __device__ __forceinline__ void done(const Unit&) const {}
};

__device__ __forceinline__ unsigned cvt_pk_bf16(float lo, float hi) { unsigned r; asm volatile("v_cvt_pk_bf16_f32 %0, %1, %2" : "=v"(r) : "v"(lo), "v"(hi)); return r; }
typedef float f32x2 __attribute__((ext_vector_type(2)));
__device__ __forceinline__ f32x2 gelu_pk(f32x2 v) {
    const f32x2 av = __builtin_elementwise_abs(v), d = av * 0.2316418882f + 1.0f;
    f32x2 t; t.x = __builtin_amdgcn_rcpf(d.x); t.y = __builtin_amdgcn_rcpf(d.y);
    f32x2 q = t * 0.5307027145f + (-0.7265760135f); q = q * t + 0.7107068705f; q = q * t + (-0.142248368f); q = q * t + 0.127414796f; q = q * t;
    const f32x2 s = (v * v) * (-0.72134752044f);
    f32x2 e; e.x = __builtin_amdgcn_exp2f(s.x); e.y = __builtin_amdgcn_exp2f(s.y);
    const f32x2 m = v * (q * e), r = v - m;
    f32x2 o; o.x = v.x < 0.f ? m.x : r.x; o.y = v.y < 0.f ? m.y : r.y; return o;
}

template <int ACT  > struct EpiBf16 {
    static constexpr bool PERM = true, AFTER_DRAIN = false; static_assert(ACT == 0 || ACT == 1, "EpiBf16: ACT is 0 (none) or 1 (gelu_pk)");
    bf16_t* O; int ldc; const float* bias; int split_cols; size_t split_stride; float scale0;
    __device__ __forceinline__ void operator()(const f32x4 (&acc)[2][2][4][2], const Unit& u, int wr, int wc, int fr, int fq) const {
        const int row0 = u.pm * BM + wr * 64 + fr; int colt = u.pn * BM; bf16_t* base = O;
        float sc = 1.f; if (split_cols) { const int t = colt / split_cols; base += (size_t)t * split_stride; colt -= t * split_cols; if (t == 0) sc = scale0; }
        const int col0 = colt + wc * 32 + 8 * fq, bcol0 = u.pn * BM + wc * 32 + 8 * fq;
        f32x4 bv[2][2];
#pragma unroll
        for (int bj = 0; bj < 2; ++bj)
#pragma unroll
            for (int n = 0; n < 2; ++n) bv[bj][n] = bias ? *(const f32x4*)(bias + bcol0 + bj * HALF + 4 * n) : (f32x4){0.f, 0.f, 0.f, 0.f};
#pragma unroll
        for (int ai = 0; ai < 2; ++ai)
#pragma unroll
            for (int m = 0; m < 4; ++m) { bf16_t* rowp = base + (size_t)(row0 + ai * HALF + m * 16) * ldc + col0;
#pragma unroll
                for (int bj = 0; bj < 2; ++bj) { f32x4 v0 = acc[ai][bj][m][0] + bv[bj][0], v1 = acc[ai][bj][m][1] + bv[bj][1];
                    if (ACT == 1) { f32x2 a = gelu_pk((f32x2){v0[0], v0[1]}), b = gelu_pk((f32x2){v0[2], v0[3]}), c = gelu_pk((f32x2){v1[0], v1[1]}), d = gelu_pk((f32x2){v1[2], v1[3]});
                        v0 = (f32x4){a.x, a.y, b.x, b.y}; v1 = (f32x4){c.x, c.y, d.x, d.y}; }
                    v0 = v0 * sc; v1 = v1 * sc; u32x4 w; w.x = cvt_pk_bf16(v0[0], v0[1]); w.y = cvt_pk_bf16(v0[2], v0[3]); w.z = cvt_pk_bf16(v1[0], v1[1]); w.w = cvt_pk_bf16(v1[2], v1[3]);
                    *(u32x4*)(rowp + bj * HALF) = w; } }
    }
};
__device__ __forceinline__ float fast_sigmoid(float x) { return __builtin_amdgcn_rcpf(1.0f + __builtin_amdgcn_exp2f(-1.44269504089f * x)); }
struct EpiSwiGLU {
    static constexpr bool PERM = true, AFTER_DRAIN = false;
    bf16_t* O; int ldc; const float* rs;
    __device__ __forceinline__ void operator()(const f32x4 (&acc)[2][2][4][2], const Unit& u, int wr, int wc, int fr, int fq) const {
        const int row0 = u.pm * BM + wr * 64 + fr, col0 = u.pn * HALF + wc * 32 + 8 * fq;
#pragma unroll
        for (int ai = 0; ai < 2; ++ai)
#pragma unroll
            for (int m = 0; m < 4; ++m) { bf16_t* rowp = O + (size_t)(row0 + ai * HALF + m * 16) * ldc + col0; const float rr = rs[row0 + ai * HALF + m * 16];
                float h[8];
#pragma unroll
                for (int n = 0; n < 2; ++n)
#pragma unroll
                    for (int j = 0; j < 4; ++j) { const float g = acc[ai][0][m][n][j] * rr, up = acc[ai][1][m][n][j] * rr; h[4 * n + j] = g * fast_sigmoid(g) * up; }
                u32x4 w; w.x = cvt_pk_bf16(h[0], h[1]); w.y = cvt_pk_bf16(h[2], h[3]); w.z = cvt_pk_bf16(h[4], h[5]); w.w = cvt_pk_bf16(h[6], h[7]);
                *(u32x4*)rowp = w; }
    }
};
struct EpiPleGate {
    static constexpr bool PERM = true, AFTER_DRAIN = false;
    const bf16_t* P; bf16_t* T; int ldc;
    __device__ __forceinline__ void operator()(const f32x4 (&acc)[2][2][4][2], const Unit& u, int wr, int wc, int fr, int fq) const {
        const int row0 = u.pm * BM + wr * 64 + fr, col0 = u.pn * BM + wc * 32 + 8 * fq;
#pragma unroll
        for (int ai = 0; ai < 2; ++ai)
#pragma unroll
            for (int m = 0; m < 4; ++m) { bf16_t* rowp = T + (size_t)(row0 + ai * HALF + m * 16) * ldc + col0; const bf16_t* srcp = P + (size_t)(row0 + ai * HALF + m * 16) * ldc + col0;
#pragma unroll
                for (int bj = 0; bj < 2; ++bj) { const u32x4 pw = *(const u32x4*)(srcp + bj * HALF);
                    float o[8];
#pragma unroll
                    for (int n = 0; n < 2; ++n)
#pragma unroll
                        for (int j = 0; j < 4; ++j) { const unsigned word = pw[2 * n + (j >> 1)]; const float pv = __uint_as_float((j & 1) ? (word & 0xffff0000u) : (word << 16));
                            o[4 * n + j] = pv * fast_sigmoid(acc[ai][bj][m][n][j]); }
                    u32x4 w; w.x = cvt_pk_bf16(o[0], o[1]); w.y = cvt_pk_bf16(o[2], o[3]); w.z = cvt_pk_bf16(o[4], o[5]); w.w = cvt_pk_bf16(o[6], o[7]);
                    *(u32x4*)(rowp + bj * HALF) = w; } }
    }
};
template <int CTRL> __device__ __forceinline__ float dpp_row_shr(float x) { return __builtin_bit_cast(float, __builtin_amdgcn_update_dpp(0, __builtin_bit_cast(int, x), CTRL, 0xf, 0xf, true)); }
__device__ __forceinline__ float fast_exp(float x) { return __builtin_amdgcn_exp2f(1.44269504089f * x); }
struct EpiProj {
    static constexpr bool PERM = true, AFTER_DRAIN = false;
    bf16_t* O; int ldc; float* vstat; const float* lbv; const float* anw; float* RE;
    __device__ __forceinline__ void operator()(f32x4 (&acc)[2][2][4][2], const Unit& u, int wr_, int wc_, int fr_, int fq_) const {
        int tz = threadIdx.x; asm volatile("" : "+v"(tz)); const int wr = tz >> 8, wc = (tz >> 6) & 3, fr = tz & 15, fq = (tz >> 4) & 3; (void)wr_; (void)wc_; (void)fr_; (void)fq_;
        const int row0 = u.pm * BM + wr * 64 + fr;
        if (u.pn < 16) {
            const int cq = 128 * u.pn + wc * 32 + 8 * fq;
            const int lane = 16 * fq + fr; const int bsrc = ((lane & 48) | 15) << 2;
#pragma clang loop unroll(disable)
            for (int c = 0; c < 8; ++c) {
                const float lb = lbv[cq + c], oml = 1.0f - lb;
#pragma unroll
                for (int ai = 0; ai < 2; ++ai) {
                    float bsc[4], kf[4], tot[4];
#pragma unroll
                    for (int m = 0; m < 4; ++m) { const float f = lb + oml * fast_sigmoid(acc[ai][1][m][0][0]); kf[m] = 1.0f - f;
                        float x = __builtin_amdgcn_logf(fmaxf(f, 1e-30f)) * 0.69314718056f;
                        x += dpp_row_shr<0x111>(x); x += dpp_row_shr<0x112>(x); x += dpp_row_shr<0x114>(x); x += dpp_row_shr<0x118>(x);
                        bsc[m] = x; tot[m] = __builtin_bit_cast(float, __builtin_amdgcn_ds_bpermute(bsrc, __builtin_bit_cast(int, x))); }
                    const float r = tot[0] + tot[1];
                    bsc[1] += tot[0]; bsc[2] += r; bsc[3] += r + tot[2];
                    if (fr == 0) { const int chunk = u.pm * 4 + ai * 2 + wr; float* rp = RE + (size_t)chunk * 2048 + cq + c; rp[0] = r; rp[(size_t)(16384 / 64) * 2048] = tot[2] + tot[3]; }
#pragma unroll
                    for (int m = 0; m < 4; ++m) { const float q = acc[ai][0][m][0][0], d = bsc[m] - r;
                        const float qh = q * fast_sigmoid(q) * fast_exp(fminf(d, 80.f)), kh = kf[m] * fast_exp(fminf(-d, 80.f));
                        const f32x4 q0 = acc[ai][0][m][0], q1 = acc[ai][0][m][1], k0 = acc[ai][1][m][0], k1 = acc[ai][1][m][1];
                        acc[ai][0][m][0] = (f32x4){q0[1], q0[2], q0[3], q1[0]}; acc[ai][0][m][1] = (f32x4){q1[1], q1[2], q1[3], qh};
                        acc[ai][1][m][0] = (f32x4){k0[1], k0[2], k0[3], k1[0]}; acc[ai][1][m][1] = (f32x4){k1[1], k1[2], k1[3], kh}; }
                }
            }
#pragma unroll
            for (int ai = 0; ai < 2; ++ai)
#pragma unroll
                for (int m = 0; m < 4; ++m) { bf16_t* rowp = O + (size_t)(row0 + ai * HALF + m * 16) * ldc + cq;
#pragma unroll
                    for (int bj = 0; bj < 2; ++bj) { const f32x4 v0 = acc[ai][bj][m][0], v1 = acc[ai][bj][m][1];
                        u32x4 w; w.x = cvt_pk_bf16(v0[0], v0[1]); w.y = cvt_pk_bf16(v0[2], v0[3]); w.z = cvt_pk_bf16(v1[0], v1[1]); w.w = cvt_pk_bf16(v1[2], v1[3]);
                        *(u32x4*)(rowp + bj * 2048) = w; } }
            return;
        }
        const int col0 = u.pn * BM + wc * 32 + 8 * fq, sec = u.pn >> 3;
        if (sec == 2) {
#pragma unroll
            for (int ai = 0; ai < 2; ++ai)
#pragma unroll
                for (int m = 0; m < 4; ++m) { bf16_t* rowp = O + (size_t)(row0 + ai * HALF + m * 16) * ldc + col0;
#pragma unroll
                    for (int bj = 0; bj < 2; ++bj) { const f32x4 v0 = acc[ai][bj][m][0], v1 = acc[ai][bj][m][1];
                        u32x4 w; w.x = cvt_pk_bf16(v0[0], v0[1]); w.y = cvt_pk_bf16(v0[2], v0[3]); w.z = cvt_pk_bf16(v1[0], v1[1]); w.w = cvt_pk_bf16(v1[2], v1[3]);
                        *(u32x4*)(rowp + bj * HALF) = w; } }
        } else if (sec == 3) {
            f32x4 wv[2][2];
#pragma unroll
            for (int bj = 0; bj < 2; ++bj) { wv[bj][0] = *(const f32x4*)(anw + (col0 - 6144) + bj * HALF); wv[bj][1] = *(const f32x4*)(anw + (col0 - 6144) + bj * HALF + 4); }
#pragma unroll
            for (int ai = 0; ai < 2; ++ai)
#pragma unroll
                for (int m = 0; m < 4; ++m) { bf16_t* rowp = O + (size_t)(row0 + ai * HALF + m * 16) * ldc + col0;
#pragma unroll
                    for (int bj = 0; bj < 2; ++bj) { f32x4 v0 = acc[ai][bj][m][0], v1 = acc[ai][bj][m][1];
#pragma unroll
                        for (int j = 0; j < 4; ++j) { v0[j] = v0[j] * fast_sigmoid(v0[j]) * wv[bj][0][j]; v1[j] = v1[j] * fast_sigmoid(v1[j]) * wv[bj][1][j]; }
                        u32x4 w; w.x = cvt_pk_bf16(v0[0], v0[1]); w.y = cvt_pk_bf16(v0[2], v0[3]); w.z = cvt_pk_bf16(v1[0], v1[1]); w.w = cvt_pk_bf16(v1[2], v1[3]);
                        *(u32x4*)(rowp + bj * HALF) = w; } }
        } else {
#pragma unroll
            for (int ai = 0; ai < 2; ++ai)
#pragma unroll
                for (int m = 0; m < 4; ++m) { const int row = row0 + ai * HALF + m * 16; bf16_t* rowp = O + (size_t)row * ldc + col0; float s = 0.f, q = 0.f;
#pragma unroll
                    for (int bj = 0; bj < 2; ++bj) { const f32x4 v0 = acc[ai][bj][m][0], v1 = acc[ai][bj][m][1];
                        const f32x2 a = gelu_pk((f32x2){v0[0], v0[1]}), b = gelu_pk((f32x2){v0[2], v0[3]}), c = gelu_pk((f32x2){v1[0], v1[1]}), d = gelu_pk((f32x2){v1[2], v1[3]});
                        s += (a.x + a.y) + (b.x + b.y) + (c.x + c.y) + (d.x + d.y);
                        q += (a.x * a.x + a.y * a.y) + (b.x * b.x + b.y * b.y) + (c.x * c.x + c.y * c.y) + (d.x * d.x + d.y * d.y);
                        u32x4 w; w.x = cvt_pk_bf16(a.x, a.y); w.y = cvt_pk_bf16(b.x, b.y); w.z = cvt_pk_bf16(c.x, c.y); w.w = cvt_pk_bf16(d.x, d.y);
                        *(u32x4*)(rowp + bj * HALF) = w; }
                    if (sec == 5) { s += __shfl_xor(s, 16); s += __shfl_xor(s, 32); q += __shfl_xor(q, 16); q += __shfl_xor(q, 32);
                        if (fq == 0) { atomicAdd(vstat + 2 * row, s); atomicAdd(vstat + 2 * row + 1, q); } } }
        }
    }
};
template <class Epi, class Sched, bool ALIGN_EPI = false, bool SP2 = false>
__device__ __forceinline__ void gemm_phase(PG8_LAS unsigned char* lds, const Gemm g, const Sched& S, const Epi& E) {
    int tid_o = threadIdx.x; asm volatile("" : "+v"(tid_o));
    const int tid = tid_o, wid = __builtin_amdgcn_readfirstlane(tid >> 6), lane = tid & 63, wr = wid >> 2, wc = wid & 3, fr = lane & 15, fq = lane >> 4;
    const int K = g.K, nt = K / BK;
    unsigned voffA[2], voffB[2];
#pragma unroll
    for (int i = 0; i < 2; ++i) { int R, C; stage_rc(tid * 16 + i * 8192, R, C); const int Rb = Epi::PERM ? ((R & ~31) + perm32(R & 31)) : R;
        voffA[i] = (unsigned)(R * K + C) * 2u; voffB[i] = (unsigned)(Rb * K + C) * 2u; }
    const size_t kstep = (size_t)(BK * 2);
    const size_t hstep = (size_t)HALF * K * 2;
    const size_t tstep = 2 * hstep;
    const unsigned ldsw = (unsigned)wid * 1024u;
    const int aoff = lds_byte(wr * 64 + fr, fq * 8), boff = lds_byte(wc * 32 + fr, fq * 8);
#define PG8_SA(b, h) (((b) * 2 + (h)) * HTB)
#define PG8_SB(b, h) ((4 + (b) * 2 + (h)) * HTB)
#define PG8_STAGE(bufoff, gbase, voff) do { _Pragma("unroll") for (int _i = 0; _i < 2; ++_i) \
        __builtin_amdgcn_global_load_lds((const unsigned*)((const char*)(gbase) + (voff)[_i]), (PG8_LAS unsigned*)(lds + (bufoff) + ldsw + _i * 8192), 16, 0, 0); } while (0)
#define PG8_LDA(dst, b, h) do { _Pragma("unroll") for (int m = 0; m < 4; ++m) _Pragma("unroll") for (int k = 0; k < 2; ++k) dst[m][k] = *(const PG8_LAS bf16x8*)(lds + PG8_SA(b, h) + aoff + m * 2048 + k * 1024); } while (0)
#define PG8_LDB(dst, b, h) do { _Pragma("unroll") for (int n = 0; n < 2; ++n) _Pragma("unroll") for (int k = 0; k < 2; ++k) dst[n][k] = *(const PG8_LAS bf16x8*)(lds + PG8_SB(b, h) + boff + n * 2048 + k * 1024); } while (0)
#define PG8_MMA(ai, bj, At, Bt) do { __builtin_amdgcn_s_setprio(1); _Pragma("unroll") for (int m = 0; m < 4; ++m) _Pragma("unroll") for (int n = 0; n < 2; ++n) _Pragma("unroll") for (int k = 0; k < 2; ++k) \
        acc[ai][bj][m][n] = __builtin_amdgcn_mfma_f32_16x16x32_bf16(Bt[n][k], At[m][k], acc[ai][bj][m][n], 0, 0, 0); __builtin_amdgcn_s_setprio(0); } while (0)
#define PG8_WAIT_V(n) asm volatile("s_waitcnt vmcnt(" #n ")" ::: "memory")
#define PG8_WAIT_L(n) asm volatile("s_waitcnt lgkmcnt(" #n ")" ::: "memory")
#define PG8_BAR __builtin_amdgcn_s_barrier()
#define PG8_SCHED __builtin_amdgcn_sched_barrier(0)
    Unit cur, nxt; int ui = 0;
    if (!S.next(0, cur)) return;
    f32x4 acc[2][2][4][2];
#pragma unroll
    for (int a = 0; a < 2; ++a)
#pragma unroll
        for (int b = 0; b < 2; ++b)
#pragma unroll
            for (int m = 0; m < 4; ++m)
#pragma unroll
                for (int n = 0; n < 2; ++n) acc[a][b][m][n] = (f32x4){0.f, 0.f, 0.f, 0.f};
    bf16x8 At[4][2], B0[2][2], B1[2][2];
    const char* cA = (const char*)g.A + (size_t)cur.pm * tstep; const char* cB = (const char*)g.Bt + (size_t)cur.pn * tstep;
    S.a_ready(cur);
    if constexpr (SP2) {
        PG8_STAGE(PG8_SB(0, 0), cB, voffB); PG8_STAGE(PG8_SB(0, 1), cB + hstep, voffB); PG8_STAGE(PG8_SA(0, 0), cA, voffA); PG8_STAGE(PG8_SA(0, 1), cA + hstep, voffA);
        if (wr == 1) PG8_BAR;
        PG8_WAIT_V(2); PG8_BAR;
        PG8_STAGE(PG8_SB(1, 0), cB + kstep, voffB); PG8_STAGE(PG8_SA(1, 0), cA + kstep, voffA); PG8_STAGE(PG8_SB(1, 1), cB + hstep + kstep, voffB);
        PG8_WAIT_V(6); PG8_BAR;
    } else {
        PG8_STAGE(PG8_SB(0, 0), cB, voffB); PG8_STAGE(PG8_SA(0, 0), cA, voffA); PG8_STAGE(PG8_SB(0, 1), cB + hstep, voffB); PG8_STAGE(PG8_SA(0, 1), cA + hstep, voffA);
        if (wr == 1) PG8_BAR;
        PG8_WAIT_V(4); PG8_BAR;
        PG8_STAGE(PG8_SB(1, 0), cB + kstep, voffB); PG8_STAGE(PG8_SA(1, 0), cA + kstep, voffA); PG8_STAGE(PG8_SB(1, 1), cB + hstep + kstep, voffB);
        PG8_WAIT_V(6); PG8_BAR;
    }
    for (;;) {
        const bool has_next = S.next(ui + 1, nxt);
        const char* nA = has_next ? (const char*)g.A + (size_t)nxt.pm * tstep : cA; const char* nB = has_next ? (const char*)g.Bt + (size_t)nxt.pn * tstep : cB;
        for (int t = 0; t < nt; t += 2) {
            const bool last = (t == nt - 2);
            const char* a1 = cA + (size_t)(t + 1) * kstep;
            const char* a2 = last ? nA : cA + (size_t)(t + 2) * kstep; const char* b2 = last ? nB : cB + (size_t)(t + 2) * kstep;
            const char* a3 = a2 + kstep; const char* b3 = b2 + kstep;
            if (last && has_next) S.a_ready(nxt);
            if constexpr (SP2) {
            PG8_LDB(B0, 0, 0); PG8_LDB(B1, 0, 1); PG8_SCHED; PG8_LDA(At, 0, 0); PG8_STAGE(PG8_SA(1, 1), a1 + hstep, voffA);
            PG8_WAIT_V(8); PG8_WAIT_L(0); PG8_BAR; PG8_MMA(0, 0, At, B0); PG8_MMA(0, 1, At, B1); PG8_BAR; PG8_SCHED;
            PG8_LDA(At, 0, 1); PG8_STAGE(PG8_SB(0, 0), b2, voffB); PG8_STAGE(PG8_SB(0, 1), b2 + hstep, voffB); PG8_STAGE(PG8_SA(0, 0), a2, voffA);
            PG8_WAIT_V(8); PG8_WAIT_L(0); PG8_BAR; PG8_MMA(1, 0, At, B0); PG8_MMA(1, 1, At, B1); PG8_BAR; PG8_SCHED;
            PG8_LDB(B0, 1, 0); PG8_LDB(B1, 1, 1); PG8_SCHED; PG8_LDA(At, 1, 0); PG8_STAGE(PG8_SA(0, 1), a2 + hstep, voffA);
            PG8_WAIT_V(8); PG8_WAIT_L(0); PG8_BAR; PG8_MMA(0, 0, At, B0); PG8_MMA(0, 1, At, B1); PG8_BAR; PG8_SCHED;
            PG8_LDA(At, 1, 1); PG8_STAGE(PG8_SB(1, 0), b3, voffB); PG8_STAGE(PG8_SB(1, 1), b3 + hstep, voffB); PG8_STAGE(PG8_SA(1, 0), a3, voffA);
            PG8_WAIT_V(8); PG8_WAIT_L(0); PG8_BAR; PG8_MMA(1, 0, At, B0); PG8_MMA(1, 1, At, B1); PG8_BAR; PG8_SCHED;
            } else {
            PG8_LDB(B0, 0, 0); PG8_SCHED; PG8_LDA(At, 0, 0); PG8_STAGE(PG8_SA(1, 1), a1 + hstep, voffA);
            PG8_WAIT_L(8); PG8_BAR; PG8_WAIT_L(0); PG8_MMA(0, 0, At, B0); PG8_BAR; PG8_SCHED;
            PG8_LDB(B1, 0, 1); PG8_STAGE(PG8_SB(0, 0), b2, voffB);
            PG8_BAR; PG8_WAIT_L(0); PG8_MMA(0, 1, At, B1); PG8_BAR;
            PG8_LDA(At, 0, 1); PG8_STAGE(PG8_SA(0, 0), a2, voffA);
            PG8_BAR; PG8_WAIT_L(0); PG8_MMA(1, 0, At, B0); PG8_BAR; PG8_SCHED;
            PG8_STAGE(PG8_SB(0, 1), b2 + hstep, voffB);
            PG8_WAIT_V(6); PG8_BAR; PG8_MMA(1, 1, At, B1); PG8_BAR;
            PG8_LDB(B0, 1, 0); PG8_SCHED; PG8_LDA(At, 1, 0); PG8_STAGE(PG8_SA(0, 1), a2 + hstep, voffA);
            PG8_WAIT_L(8); PG8_BAR; PG8_WAIT_L(0); PG8_MMA(0, 0, At, B0); PG8_BAR; PG8_SCHED;
            PG8_LDB(B1, 1, 1); PG8_STAGE(PG8_SB(1, 0), b3, voffB);
            PG8_BAR; PG8_WAIT_L(0); PG8_MMA(0, 1, At, B1); PG8_BAR;
            PG8_LDA(At, 1, 1); PG8_STAGE(PG8_SA(1, 0), a3, voffA);
            PG8_BAR; PG8_WAIT_L(0); PG8_MMA(1, 0, At, B0); PG8_BAR; PG8_SCHED;
            PG8_STAGE(PG8_SB(1, 1), b3 + hstep, voffB);
            PG8_WAIT_V(6); PG8_BAR; PG8_MMA(1, 1, At, B1); PG8_BAR;
            }
        }
        if constexpr (ALIGN_EPI) { if (wr == 0) PG8_BAR; }
        if constexpr (!Epi::AFTER_DRAIN) { E(acc, cur, wr, wc, fr, fq); S.done(cur); }
        if (!has_next) break;
#pragma unroll
        for (int a = 0; a < 2; ++a)
#pragma unroll
            for (int b = 0; b < 2; ++b)
#pragma unroll
                for (int m = 0; m < 4; ++m)
#pragma unroll
                    for (int n = 0; n < 2; ++n) acc[a][b][m][n] = (f32x4){0.f, 0.f, 0.f, 0.f};
        cur = nxt; cA = nA; cB = nB; ++ui;
        if constexpr (ALIGN_EPI) { if (wr == 1) PG8_BAR; }
    }
    PG8_WAIT_V(0);
    if constexpr (!ALIGN_EPI) { if (wr == 0) PG8_BAR; }
    PG8_BAR;
    if constexpr (Epi::AFTER_DRAIN) { E.fused(acc, cur, wr, wc, fr, fq, lds, wid, lane); S.done(cur); }
#undef PG8_SA
#undef PG8_SB
#undef PG8_STAGE
#undef PG8_LDA
#undef PG8_LDB
#undef PG8_MMA
#undef PG8_WAIT_V
#undef PG8_WAIT_L
#undef PG8_BAR
#undef PG8_SCHED
}
}
constexpr int NWAVES = 8;
constexpr int BATCH = 4, T = 4096, D = 4096, M = BATCH * T;
constexpr int NIN = 12288, AW = 2048, FF = 11008, NGU = 2 * FF, PLE = 256, NHEAD = 16, HD = 128;
constexpr int C_Q = 0, C_F = 2048, C_I = 4096, C_G = 6144, C_U = 8192, C_V = 10240;
constexpr float EPS = 1e-6f;

constexpr size_t MiB = 1u << 20;
constexpr size_t WS_CTL = 0, CTL_ZERO_BYTES = 1 * MiB;
constexpr size_t WS_LB = 1 * MiB;
constexpr size_t WS_RS2 = 1 * MiB + 65536;
constexpr size_t WS_VSTAT = 1 * MiB + 131072;
constexpr size_t WS_WSPB = 1 * MiB + 524288;
constexpr size_t WS_WIN = 2 * MiB;
constexpr size_t WS_WOUT = 98 * MiB;
constexpr size_t WS_WGU = 130 * MiB;
constexpr size_t WS_WDN = 302 * MiB;
constexpr size_t WS_WPG = 388 * MiB;
constexpr size_t WS_WPLE = 420 * MiB;
constexpr size_t WS_H = 422 * MiB;
constexpr size_t WS_PROJ = 550 * MiB;
constexpr size_t WS_PB = 934 * MiB;
constexpr size_t WS_END = 942 * MiB;
constexpr size_t WS_FF = 2 * MiB;
constexpr int CW_BAR = 4096;

constexpr int RING_BYTES = 131072, LDSCTL_OFF = RING_BYTES, MISC_OFF = LDSCTL_OFF + 320, LDS_BYTES = 147456;

#define GAS __attribute__((address_space(1)))
#define LAS __attribute__((address_space(3)))
typedef unsigned short bf16;
typedef unsigned v4u __attribute__((ext_vector_type(4)));
typedef unsigned v2u __attribute__((ext_vector_type(2)));
typedef float f32x4 __attribute__((ext_vector_type(4)));
typedef float f32x16 __attribute__((ext_vector_type(16)));
typedef short bf16x8 __attribute__((ext_vector_type(8)));
typedef GAS unsigned gu32;
#define LDS_WAIT() asm volatile("s_waitcnt lgkmcnt(0)" ::: "memory")
#define VM_WAIT() asm volatile("s_waitcnt vmcnt(0)" ::: "memory")
__device__ __forceinline__ unsigned f2bf(float f) { unsigned u = __builtin_bit_cast(unsigned, f); return (u + 0x7fffu + ((u >> 16) & 1u)) >> 16; }
__device__ __forceinline__ unsigned pk2(float lo, float hi) { return f2bf(lo) | (f2bf(hi) << 16); }
__device__ __forceinline__ float bf_lo(unsigned w) { return __uint_as_float(w << 16); }
__device__ __forceinline__ float bf_hi(unsigned w) { return __uint_as_float(w & 0xffff0000u); }
__device__ __forceinline__ float bf2f(bf16 b) { return __uint_as_float(((unsigned)b) << 16); }
__device__ __forceinline__ float sigmoidf_(float x) { return 1.0f / (1.0f + __expf(-x)); }
__device__ __forceinline__ float gelu1(float v) {
    const float av = fabsf(v), t = __builtin_amdgcn_rcpf(av * 0.2316418882f + 1.0f);
    float q = t * 0.5307027145f + (-0.7265760135f); q = q * t + 0.7107068705f; q = q * t + (-0.142248368f); q = q * t + 0.127414796f; q = q * t;
    const float e = __builtin_amdgcn_exp2f((v * v) * (-0.72134752044f));
    const float m = v * (q * e);
    return v < 0.f ? m : v - m;
}
__device__ __forceinline__ float wave_sum(float v) {
#pragma unroll
    for (int o = 1; o < 64; o <<= 1) v += __shfl_xor(v, o);
    return v;
}
#define XB_TMO      128
#define XB_XCNT(j)  (256  + 64 * (j))
#define XB_XSUB(j)  (1280 + 64 * (j))
#define XB_XGEN(j)  (2304 + 64 * (j))
#define XB_TOP      3328
#define XB_TOPGEN   3392
#define XCD_BAR_WORDS 3456
#define XB_SPIN_CAP (1u << 18)

__device__ __forceinline__ unsigned xb_ld(unsigned* p)              { return __hip_atomic_load(p, __ATOMIC_RELAXED, __HIP_MEMORY_SCOPE_AGENT); }
__device__ __forceinline__ unsigned xb_add(unsigned* p, unsigned v) { return __hip_atomic_fetch_add(p, v, __ATOMIC_RELAXED, __HIP_MEMORY_SCOPE_AGENT); }
__device__ __forceinline__ unsigned xb_xcc_id() { return (unsigned)__builtin_amdgcn_s_getreg((3 << 11) | 20) & 0xFu; }
#define XB_SPIN(cond, bar) do { unsigned _sp = 0; while (cond) { __builtin_amdgcn_s_sleep(1); \
    if ((++_sp & 255u) == 0u) { if (xb_ld(&(bar)[XB_TMO])) break; if (_sp > XB_SPIN_CAP) { atomicAdd(&(bar)[XB_TMO], 1u); break; } } } } while (0)

struct XcdBarrier {
    unsigned* bar; unsigned x;
    volatile LAS unsigned* st;
};

__device__ __forceinline__ XcdBarrier xcd_barrier_post(unsigned* bar, volatile LAS unsigned* st) {
    XcdBarrier b; b.bar = bar; b.x = xb_xcc_id(); b.st = st;
    if (threadIdx.x == 0) (void)xb_add(&bar[XB_XCNT(b.x)], 1u);
    return b;
}
__device__ __forceinline__ void xcd_barrier_complete(unsigned* bar, unsigned x, unsigned& nloc, unsigned& nx) {
    const unsigned G = gridDim.x * gridDim.y * gridDim.z;
    unsigned sum, cnt, mine, sp = 0u;
    for (;;) {
        sum = 0u; cnt = 0u; mine = 0u;
#pragma unroll
        for (unsigned j = 0; j < 16; ++j) { const unsigned c = xb_ld(&bar[XB_XCNT(j)]); sum += c; cnt += (c > 0u) ? 1u : 0u; mine = (j == x) ? c : mine; }
        if (sum == G) break;
        __builtin_amdgcn_s_sleep(1);
        if ((++sp & 255u) == 0u) { if (xb_ld(&bar[XB_TMO])) break; if (sp > XB_SPIN_CAP) { atomicAdd(&bar[XB_TMO], 1u); break; } }
    }
    nloc = mine > 0u ? mine : 1u; nx = cnt > 0u ? cnt : 1u;
}

__device__ __forceinline__ void xcd_barrier(const XcdBarrier& b) {
    asm volatile("s_waitcnt vmcnt(0)" ::: "memory");
    __syncthreads();
    if (threadIdx.x == 0) {
        unsigned* bar = b.bar;
        __builtin_amdgcn_s_waitcnt(0);
        unsigned nloc = b.st[0], nx = b.st[1];
        if (nloc == 0u) { xcd_barrier_complete(bar, b.x, nloc, nx); b.st[0] = nloc; b.st[1] = nx; }
        const unsigned old = xb_add(&bar[XB_XSUB(b.x)], 1u);
        const unsigned gen = old / nloc;
        if (old + 1u == (gen + 1u) * nloc) {
            __builtin_amdgcn_fence(__ATOMIC_RELEASE, "agent");
            asm volatile("s_waitcnt vmcnt(0)" ::: "memory");
            const unsigned og = xb_add(&bar[XB_TOP], 1u);
            const unsigned tg = og / nx;
            if (og + 1u == (tg + 1u) * nx) xb_add(&bar[XB_TOPGEN], 1u);
            else XB_SPIN(xb_ld(&bar[XB_TOPGEN]) == tg, bar);
            __builtin_amdgcn_fence(__ATOMIC_ACQUIRE, "agent");
            xb_add(&bar[XB_XGEN(b.x)], 1u);
            asm volatile("s_waitcnt vmcnt(0)" ::: "memory");
        } else {
            XB_SPIN(xb_ld(&bar[XB_XGEN(b.x)]) == gen, bar);
            __builtin_amdgcn_fence(__ATOMIC_ACQUIRE, "agent");
            asm volatile("s_waitcnt vmcnt(0)" ::: "memory");
        }
    }
    __syncthreads();
}
__device__ __forceinline__ void p0_transpose_item(const float* W, int K, int N, bf16* WT, int k0, int n0, int drow0, LAS float* scr, int lane, const float* kscale = nullptr) {
    float v[32];
#pragma unroll
    for (int i = 0; i < 32; ++i) { const int kk = 2 * i + (lane >> 5); v[i] = W[(size_t)(k0 + kk) * N + n0 + (lane & 31)]; }
    if (kscale) {
#pragma unroll
        for (int i = 0; i < 32; ++i) { const int kk = 2 * i + (lane >> 5); v[i] *= kscale[k0 + kk]; } }
#pragma unroll
    for (int i = 0; i < 32; ++i) { const int kk = 2 * i + (lane >> 5); scr[kk * 33 + (lane & 31)] = v[i]; }
    LDS_WAIT(); asm volatile("" ::: "memory");
    const int c = lane & 7;
#pragma unroll
    for (int j = 0; j < 4; ++j) { const int n = (lane >> 3) + 8 * j; const LAS float* s = scr + (8 * c) * 33 + n;
        v4u o; o.x = pk2(s[0 * 33], s[1 * 33]); o.y = pk2(s[2 * 33], s[3 * 33]); o.z = pk2(s[4 * 33], s[5 * 33]); o.w = pk2(s[6 * 33], s[7 * 33]);
        *(GAS v4u*)(WT + (size_t)(drow0 + n) * K + k0 + 8 * c) = o; }
    LDS_WAIT(); asm volatile("" ::: "memory");
}
__device__ __forceinline__ void load_row_f32(const float* row, int lane, f32x4 (&v)[16]) {
    const GAS f32x4* p = (const GAS f32x4*)row + lane;
#pragma unroll
    for (int j = 0; j < 16; ++j) v[j] = p[64 * j];
}
__device__ __forceinline__ void load_row_bf16(const bf16* row, int lane, f32x4 (&v)[16]) {
    const GAS v2u* p = (const GAS v2u*)row + lane;
#pragma unroll
    for (int j = 0; j < 16; ++j) { const v2u w = p[64 * j]; v[j] = (f32x4){bf_lo(w.x), bf_hi(w.x), bf_lo(w.y), bf_hi(w.y)}; }
}
__device__ __forceinline__ float row_sumsq(const f32x4 (&v)[16]) {
    float s = 0.f;
#pragma unroll
    for (int j = 0; j < 16; ++j) s += (v[j].x * v[j].x + v[j].y * v[j].y) + (v[j].z * v[j].z + v[j].w * v[j].w);
    return wave_sum(s);
}
__device__ __forceinline__ void store_row_bf16(bf16* row, int lane, const f32x4 (&v)[16]) {
    GAS v2u* p = (GAS v2u*)row + lane;
#pragma unroll
    for (int j = 0; j < 16; ++j) { v2u w; w.x = pk2(v[j].x, v[j].y); w.y = pk2(v[j].z, v[j].w); p[64 * j] = w; }
}
__device__ __forceinline__ void store_row_f32(float* row, int lane, const f32x4 (&v)[16]) {
    GAS f32x4* p = (GAS f32x4*)row + lane;
#pragma unroll
    for (int j = 0; j < 16; ++j) p[64 * j] = v[j];
}
template <int MODE> __device__ __forceinline__ void row_pass(const bf16* Ab, const float* Xin, float* Xout, bf16* Hb, const float* w1, float* rs, int gw, int ngw, int lane) {
    for (int m = gw; m < M; m += ngw) {
        asm volatile("" ::: "memory");
        v2u ap[16]; f32x4 x[16];
        { const GAS v2u* p = (const GAS v2u*)(Ab + (size_t)m * D) + lane;
#pragma unroll
          for (int j = 0; j < 16; ++j) ap[j] = p[64 * j]; }
        if (MODE == 0) load_row_f32(Xin + (size_t)m * D, lane, x); else load_row_bf16(Hb + (size_t)m * D, lane, x);
        float s = 0.f;
#pragma unroll
        for (int j = 0; j < 16; ++j) { const float a0 = bf_lo(ap[j].x), a1 = bf_hi(ap[j].x), a2 = bf_lo(ap[j].y), a3 = bf_hi(ap[j].y); s += (a0 * a0 + a1 * a1) + (a2 * a2 + a3 * a3); }
        const float r1 = rsqrtf(wave_sum(s) * (1.0f / D) + EPS);
        asm volatile("" ::: "memory");
        const GAS f32x4* wp1 = (const GAS f32x4*)w1 + lane; GAS f32x4* xo = (GAS f32x4*)(Xout + (size_t)m * D) + lane; GAS v2u* ho = (GAS v2u*)(Hb + (size_t)m * D) + lane;
        float s2 = 0.f;
#pragma unroll
        for (int jg = 0; jg < 16; jg += 4) {
#pragma unroll
            for (int j = jg; j < jg + 4; ++j) { const f32x4 w = wp1[64 * j]; const f32x4 a = (f32x4){bf_lo(ap[j].x), bf_hi(ap[j].x), bf_lo(ap[j].y), bf_hi(ap[j].y)}; const f32x4 y = x[j] + a * r1 * w;
                if (MODE == 2) xo[64 * j] = y; else { v2u o; o.x = pk2(y.x, y.y); o.y = pk2(y.z, y.w); ho[64 * j] = o; }
                if (MODE == 0) s2 += (y.x * y.x + y.y * y.y) + (y.z * y.z + y.w * y.w); }
            asm volatile("" ::: "memory"); }
        if (MODE == 0) { const float r2 = rsqrtf(wave_sum(s2) * (1.0f / D) + EPS); if (lane == 0) rs[m] = r2; }
    }
}

#define MFMA32(a, b, c) __builtin_amdgcn_mfma_f32_32x32x16_bf16((a), (b), (c), 0, 0, 0)
__device__ __forceinline__ int crow(int reg, int h) { return (reg & 3) + 8 * (reg >> 2) + 4 * h; }
constexpr int QH_OFF = 0, KH_OFF = 17408, KHT_OFF = 34816, VT_OFF = 53248, AM_OFF = 71680, ST_OFF = 80896, OL_OFF = 0;
constexpr int LDQ = 272  , LDT = 144  , LDO = 528  ;
static_assert(ST_OFF + 128 * LDQ <= RING_BYTES && 64 * LDO <= KHT_OFF, "hgrn2 LDS map");

__device__ __forceinline__ void hgrn2_unit(LAS unsigned char* L, const bf16* proj, const float* RE, bf16* mixin, int b, int h, int tid) {
    const int lane = tid & 63, wave = __builtin_amdgcn_readfirstlane(tid >> 6), r32 = lane & 31, hh = lane >> 5;
    const int trow = tid >> 3, c16 = tid & 7;
    for (int e = tid; e < 1024; e += 512) { const int t = e >> 5, s = 32 + (e & 31); *(LAS bf16*)(L + AM_OFF + t * LDT + s * 2) = (bf16)0; }
    f32x16 S0, S1;
#pragma unroll
    for (int i = 0; i < 16; ++i) { S0[i] = 0.f; S1[i] = 0.f; }
    const int svi = wave >> 1, ski = 2 * (wave & 1);
    const int oti = wave >> 2, ovi = wave & 3;
    const int kk0 = 32 * ski + r32, kk1 = kk0 + 32;
    const size_t tok0 = (size_t)b * T;
    const bf16* prow = proj + (tok0 + trow) * NIN + HD * h + 16 * c16;
    const bf16* prow2 = proj + (tok0 + lane) * NIN + HD * h + 16 * wave;
    const float* rep = RE + (size_t)(b * (T / 64)) * 2048 + HD * h;
    v4u tq0, tq1, tk0, tk1, tv0, tv1; float pr0, pr1, pe0, pe1, ce0 = 0.f, ce1 = 0.f;
#define HG_LOAD(nn) do { const bf16* p_ = prow2 + (size_t)(nn) * 64 * NIN; \
        tq0 = *(const GAS v4u*)(p_ + C_Q); tq1 = *(const GAS v4u*)(p_ + C_Q + 8); tk0 = *(const GAS v4u*)(p_ + C_F); tk1 = *(const GAS v4u*)(p_ + C_F + 8); \
        tv0 = *(const GAS v4u*)(p_ + C_I); tv1 = *(const GAS v4u*)(p_ + C_I + 8); \
        const float* r_ = rep + (size_t)(nn) * 2048; pr0 = r_[kk0]; pr1 = r_[kk1]; pe0 = r_[(size_t)(M / 64) * 2048 + kk0]; pe1 = r_[(size_t)(M / 64) * 2048 + kk1]; } while (0)
    HG_LOAD(0);
    for (int n = 0; n < T / 64; ++n) {
        const size_t row0 = tok0 + 64 * n;
        *(LAS v4u*)(L + QH_OFF + lane * LDQ + 32 * wave) = tq0; *(LAS v4u*)(L + QH_OFF + lane * LDQ + 32 * wave + 16) = tq1;
        *(LAS v4u*)(L + KH_OFF + lane * LDQ + 32 * wave) = tk0; *(LAS v4u*)(L + KH_OFF + lane * LDQ + 32 * wave + 16) = tk1;
        {   const unsigned kw[8] = {tk0.x, tk0.y, tk0.z, tk0.w, tk1.x, tk1.y, tk1.z, tk1.w}, vw[8] = {tv0.x, tv0.y, tv0.z, tv0.w, tv1.x, tv1.y, tv1.z, tv1.w};
#pragma unroll
            for (int j = 0; j < 8; ++j) {
                *(LAS bf16*)(L + KHT_OFF + (16 * wave + 2 * j) * LDT + lane * 2) = (bf16)(kw[j] & 0xffffu); *(LAS bf16*)(L + KHT_OFF + (16 * wave + 2 * j + 1) * LDT + lane * 2) = (bf16)(kw[j] >> 16);
                *(LAS bf16*)(L + VT_OFF + (16 * wave + 2 * j) * LDT + lane * 2) = (bf16)(vw[j] & 0xffffu); *(LAS bf16*)(L + VT_OFF + (16 * wave + 2 * j + 1) * LDT + lane * 2) = (bf16)(vw[j] >> 16); } }
        const v4u gq0 = *(const GAS v4u*)(prow + (size_t)n * 64 * NIN + C_G), gq1 = *(const GAS v4u*)(prow + (size_t)n * 64 * NIN + C_G + 8);
        float er0 = __expf(pr0 + ce0), er1 = __expf(pr1 + ce1);
        ce0 = pe0; ce1 = pe1;
        asm volatile("" : "+v"(er0), "+v"(er1), "+v"(ce0), "+v"(ce1));
#pragma unroll
        for (int i = 0; i < 16; ++i) { S0[i] *= er0; S1[i] *= er1; const int v = 32 * svi + crow(i, hh);
            *(LAS bf16*)(L + ST_OFF + v * LDQ + kk0 * 2) = (bf16)f2bf(S0[i]); *(LAS bf16*)(L + ST_OFF + v * LDQ + kk1 * 2) = (bf16)f2bf(S1[i]); }
        if (n + 1 < T / 64) HG_LOAD(n + 1);
        __syncthreads();
        f32x16 O;
#pragma unroll
        for (int i = 0; i < 16; ++i) O[i] = 0.f;
#pragma unroll
        for (int ks = 0; ks < 8; ++ks) { const bf16x8 a = *(const LAS bf16x8*)(L + QH_OFF + (32 * oti + r32) * LDQ + 32 * ks + 16 * hh);
            const bf16x8 bb = *(const LAS bf16x8*)(L + ST_OFF + (32 * ovi + r32) * LDQ + 32 * ks + 16 * hh); O = MFMA32(a, bb, O); }
#pragma unroll
        for (int ss = 0; ss < 4; ++ss) { const bf16x8 a = *(const LAS bf16x8*)(L + VT_OFF + (32 * svi + r32) * LDT + 32 * ss + 16 * hh);
            const bf16x8 b0 = *(const LAS bf16x8*)(L + KHT_OFF + (32 * ski + r32) * LDT + 32 * ss + 16 * hh);
            const bf16x8 b1 = *(const LAS bf16x8*)(L + KHT_OFF + (32 * ski + 32 + r32) * LDT + 32 * ss + 16 * hh);
            S0 = MFMA32(a, b0, S0); S1 = MFMA32(a, b1, S1); }
        if (wave < 3) {
            const int ti = wave ? 1 : 0, si = (wave == 2) ? 1 : 0;
            f32x16 Sc;
#pragma unroll
            for (int i = 0; i < 16; ++i) Sc[i] = 0.f;
#pragma unroll
            for (int ks = 0; ks < 8; ++ks) { const bf16x8 a = *(const LAS bf16x8*)(L + QH_OFF + (32 * ti + r32) * LDQ + 32 * ks + 16 * hh);
                const bf16x8 bb = *(const LAS bf16x8*)(L + KH_OFF + (32 * si + r32) * LDQ + 32 * ks + 16 * hh); Sc = MFMA32(a, bb, Sc); }
#pragma unroll
            for (int i = 0; i < 16; ++i) { const int t = 32 * ti + crow(i, hh), s = 32 * si + r32; const float val = (s <= t) ? Sc[i] : 0.f;
                *(LAS bf16*)(L + AM_OFF + t * LDT + s * 2) = (bf16)f2bf(val); }
        }
        __syncthreads();
#pragma unroll
        for (int ss = 0; ss < 4; ++ss) { const bf16x8 a = *(const LAS bf16x8*)(L + AM_OFF + (32 * oti + r32) * LDT + 32 * ss + 16 * hh);
            const bf16x8 bb = *(const LAS bf16x8*)(L + VT_OFF + (32 * ovi + r32) * LDT + 32 * ss + 16 * hh); O = MFMA32(a, bb, O); }
#pragma unroll
        for (int i = 0; i < 16; ++i) { const int t = 32 * oti + crow(i, hh), v = 32 * ovi + r32; *(LAS float*)(L + OL_OFF + t * LDO + v * 4) = O[i]; }
        __syncthreads();
        {
            const LAS f32x4* op = (const LAS f32x4*)(L + OL_OFF + trow * LDO + c16 * 64);
            f32x4 o4[4]; float ssq = 0.f;
#pragma unroll
            for (int q = 0; q < 4; ++q) { o4[q] = op[q]; ssq += (o4[q].x * o4[q].x + o4[q].y * o4[q].y) + (o4[q].z * o4[q].z + o4[q].w * o4[q].w); }
            ssq += __shfl_xor(ssq, 1); ssq += __shfl_xor(ssq, 2); ssq += __shfl_xor(ssq, 4);
            const float rstd = rsqrtf(ssq * (1.0f / HD) + EPS);
            GAS v4u* dst = (GAS v4u*)(mixin + (row0 + trow) * D + HD * h + 16 * c16);
#pragma unroll
            for (int half = 0; half < 2; ++half) { const v4u g = half ? gq1 : gq0; const f32x4 oa = o4[2 * half], ob = o4[2 * half + 1];
                v4u w; w.x = pk2(oa.x * rstd * bf_lo(g.x), oa.y * rstd * bf_hi(g.x)); w.y = pk2(oa.z * rstd * bf_lo(g.y), oa.w * rstd * bf_hi(g.y));
                w.z = pk2(ob.x * rstd * bf_lo(g.z), ob.y * rstd * bf_hi(g.z)); w.w = pk2(ob.z * rstd * bf_lo(g.w), ob.w * rstd * bf_hi(g.w)); dst[half] = w; }
        }
        __syncthreads();
    }
#undef HG_LOAD
}

constexpr int GA_OFF = 0, GV_OFF = 34816, ZL_OFF = 0;
static_assert(128 * LDO <= 2 * 34816, "gmlp LDS map");
__device__ __forceinline__ void gmlp_unit(LAS unsigned char* L, const bf16* proj, const float* vstat, const float* lnw, const float* lnb, const bf16* wspb, const float* bsp, bf16* mixin, int b, int n, int g, int tid) {
    const int lane = tid & 63, wave = __builtin_amdgcn_readfirstlane(tid >> 6), r32 = lane & 31, hh = lane >> 5;
    const size_t row0 = (size_t)b * T + 128 * n;
    const int tr = tid >> 2, dq = tid & 3;
    {
        const GAS v4u* wp = (const GAS v4u*)(wspb + ((size_t)g * 128 + tr) * 128 + 32 * dq);
        LAS v4u* dst = (LAS v4u*)(L + GA_OFF + tr * LDQ + 64 * dq);
        const v4u w0 = wp[0], w1 = wp[1], w2 = wp[2], w3 = wp[3];
        dst[0] = w0; dst[1] = w1; dst[2] = w2; dst[3] = w3;
    }
    {
        const size_t row = row0 + tr;
        const float sm = vstat[2 * row], sq = vstat[2 * row + 1];
        const float mean = sm * (1.0f / AW), var = fmaxf(sq * (1.0f / AW) - mean * mean, 0.f), rstd = rsqrtf(var + EPS);
        const GAS v4u* vp = (const GAS v4u*)(proj + row * NIN + C_V + 128 * g + 32 * dq);
        const GAS f32x4* lw = (const GAS f32x4*)(lnw + 128 * g + 32 * dq); const GAS f32x4* lb4 = (const GAS f32x4*)(lnb + 128 * g + 32 * dq);
        LAS bf16* dst = (LAS bf16*)(L + GV_OFF + (32 * dq) * LDQ + tr * 2);
#pragma unroll
        for (int q = 0; q < 4; ++q) { const v4u w = vp[q]; const f32x4 wa = lw[2 * q], wb = lw[2 * q + 1], ba = lb4[2 * q], bb = lb4[2 * q + 1];
            const float xv[8] = {bf_lo(w.x), bf_hi(w.x), bf_lo(w.y), bf_hi(w.y), bf_lo(w.z), bf_hi(w.z), bf_lo(w.w), bf_hi(w.w)};
            const float wv[8] = {wa.x, wa.y, wa.z, wa.w, wb.x, wb.y, wb.z, wb.w}, bv[8] = {ba.x, ba.y, ba.z, ba.w, bb.x, bb.y, bb.z, bb.w};
#pragma unroll
            for (int j = 0; j < 8; ++j) *(LAS bf16*)((LAS unsigned char*)dst + (8 * q + j) * LDQ) = (bf16)f2bf((xv[j] - mean) * rstd * wv[j] + bv[j]); }
    }
    __syncthreads();
    const int ti = wave >> 1, di0 = 2 * (wave & 1);
    f32x16 Z0, Z1;
#pragma unroll
    for (int i = 0; i < 16; ++i) { Z0[i] = 0.f; Z1[i] = 0.f; }
    for (int ss = 0; ss < 2 * ti + 2; ++ss) { const bf16x8 a = *(const LAS bf16x8*)(L + GA_OFF + (32 * ti + r32) * LDQ + 32 * ss + 16 * hh);
        const bf16x8 b0 = *(const LAS bf16x8*)(L + GV_OFF + (32 * di0 + r32) * LDQ + 32 * ss + 16 * hh);
        const bf16x8 b1 = *(const LAS bf16x8*)(L + GV_OFF + (32 * di0 + 32 + r32) * LDQ + 32 * ss + 16 * hh);
        Z0 = MFMA32(a, b0, Z0); Z1 = MFMA32(a, b1, Z1); }
    __syncthreads();
#pragma unroll
    for (int i = 0; i < 16; ++i) { const int t = 32 * ti + crow(i, hh); const float bs = bsp[g * 128 + t];
        *(LAS float*)(L + ZL_OFF + t * LDO + (32 * di0 + r32) * 4) = Z0[i] + bs; *(LAS float*)(L + ZL_OFF + t * LDO + (32 * di0 + 32 + r32) * 4) = Z1[i] + bs; }
    __syncthreads();
    {
        const LAS f32x4* zp = (const LAS f32x4*)(L + ZL_OFF + tr * LDO + 128 * dq);
        const GAS v4u* up = (const GAS v4u*)(proj + (row0 + tr) * NIN + C_U + 128 * g + 32 * dq);
        GAS v4u* op = (GAS v4u*)(mixin + (row0 + tr) * D + AW + 128 * g + 32 * dq);
#pragma unroll
        for (int q = 0; q < 4; ++q) { const v4u uw = up[q]; const f32x4 za = zp[2 * q], zb = zp[2 * q + 1];
            v4u o; o.x = pk2(bf_lo(uw.x) * za.x, bf_hi(uw.x) * za.y); o.y = pk2(bf_lo(uw.y) * za.z, bf_hi(uw.y) * za.w);
            o.z = pk2(bf_lo(uw.z) * zb.x, bf_hi(uw.z) * zb.y); o.w = pk2(bf_lo(uw.w) * zb.z, bf_hi(uw.w) * zb.w); op[q] = o; }
    }
    __syncthreads();
}
struct Args { const float* in[20]; float* out; unsigned char* ws; };
__global__ void __launch_bounds__(NWAVES * 64, 2) hymba_fwd(Args args) {
    extern __shared__ __attribute__((aligned(16))) unsigned char lds[];
    LAS unsigned char* L = (LAS unsigned char*)lds;
    volatile LAS unsigned* MISC = (volatile LAS unsigned*)(L + MISC_OFF);
#define FRESH_IDS() int tid = threadIdx.x; asm volatile("" : "+v"(tid)); const int lane = tid & 63, wave = __builtin_amdgcn_readfirstlane(tid >> 6), gw = blockIdx.x * NWAVES + wave; (void)lane; (void)gw
    const int G = gridDim.x, NGW = G * NWAVES;
    unsigned char* ws = args.ws;
    gu32* ctl = (gu32*)(ws + WS_CTL);
    const float* x = args.in[0]; const float* p = args.in[1]; const float* pre_mix_w = args.in[2]; const float* w_in = args.in[3]; const float* lb_param = args.in[4];
    const float* a_norm_w = args.in[5]; const float* ln_w = args.in[6]; const float* ln_b = args.in[7]; const float* w_sp = args.in[8]; const float* b_sp = args.in[9];
    const float* w_out = args.in[10]; const float* post_mix_w = args.in[11]; const float* pre_ffn_w = args.in[12]; const float* w_gate = args.in[13]; const float* w_up = args.in[14];
    const float* w_down = args.in[15]; const float* post_ffn_w = args.in[16]; const float* w_ple = args.in[17]; const float* w_pg = args.in[18]; const float* post_ple_w = args.in[19];
    float* out = args.out;
    float* lbv = (float*)(ws + WS_LB); float* rs2 = (float*)(ws + WS_RS2); float* vstat = (float*)(ws + WS_VSTAT); bf16* WSPB = (bf16*)(ws + WS_WSPB); bf16* PW = (bf16*)out; float* RE = out + (size_t)32 * 1024 * 1024;
    bf16* Win_t = (bf16*)(ws + WS_WIN); bf16* Wout_t = (bf16*)(ws + WS_WOUT); bf16* Wgu_t = (bf16*)(ws + WS_WGU); bf16* Wdn_t = (bf16*)(ws + WS_WDN);
    bf16* Wpg_t = (bf16*)(ws + WS_WPG); bf16* Wple_t = (bf16*)(ws + WS_WPLE);
    bf16* HB = (bf16*)(ws + WS_H); bf16* PROJ = (bf16*)(ws + WS_PROJ); bf16* PB = (bf16*)(ws + WS_PB); bf16* FFB = (bf16*)(ws + WS_FF);

    for (int u = threadIdx.x; u < (LDS_BYTES - LDSCTL_OFF) / 4; u += NWAVES * 64) ((LAS unsigned*)(L + LDSCTL_OFF))[u] = 0u;
    __syncthreads();
    XcdBarrier bar = xcd_barrier_post((unsigned*)(ctl + CW_BAR), MISC + 8);

    {
        FRESH_IDS();
        LAS float* scr = (LAS float*)(L + wave * 16384);
        constexpr int I_IN = (D / 64) * (NIN / 32), I_OUT = (D / 64) * (D / 32), I_PLE = (PLE / 64) * (D / 32);
        constexpr int NITEMS = I_IN + I_OUT + I_PLE;
        for (int it = gw; it < NITEMS; it += NGW) {
            int r = it;
            if (r < I_IN) { const int nb = NIN / 32, n0 = 32 * (r % nb);
                const int dr = n0 < 2048 ? 256 * (n0 >> 7) + (n0 & 127) : (n0 < 4096 ? 256 * ((n0 - 2048) >> 7) + 128 + (n0 & 127) : n0);
                p0_transpose_item(w_in, D, NIN, Win_t, 64 * (r / nb), n0, dr, scr, lane); continue; } r -= I_IN;
            if (r < I_OUT) { const int nb = D / 32; p0_transpose_item(w_out, D, D, Wout_t, 64 * (r / nb), 32 * (r % nb), 32 * (r % nb), scr, lane); continue; } r -= I_OUT;
            { const int nb = D / 32; p0_transpose_item(w_ple, PLE, D, Wple_t, 64 * (r / nb), 32 * (r % nb), 32 * (r % nb), scr, lane); }
        }
        for (int e = blockIdx.x * (NWAVES * 64) + tid; e < 16 * 128 * 128; e += G * NWAVES * 64) { const int tt = (e >> 7) & 127, ss = e & 127; WSPB[e] = (bf16)f2bf(ss <= tt ? w_sp[e] : 0.f); }
        for (int e = blockIdx.x * (NWAVES * 64) + tid; e < 2 * M; e += G * NWAVES * 64) vstat[e] = 0.f;
        for (int m = gw; m < M; m += NGW) {
            asm volatile("" ::: "memory");
            f32x4 v[16]; load_row_f32(x + (size_t)m * D, lane, v);
            const float r = rsqrtf(row_sumsq(v) * (1.0f / D) + EPS);
            const GAS f32x4* wp = (const GAS f32x4*)pre_mix_w + lane;
#pragma unroll
            for (int j = 0; j < 16; ++j) v[j] = v[j] * r * wp[64 * j];
            store_row_bf16(HB + (size_t)m * D, lane, v);
        }
        for (int m = gw; m < M; m += NGW) {
            const f32x4 v = ((const GAS f32x4*)(p + (size_t)m * PLE))[lane]; v2u w; w.x = pk2(v.x, v.y); w.y = pk2(v.z, v.w); ((GAS v2u*)(PB + (size_t)m * PLE))[lane] = w;
        }
        if (blockIdx.x == 0) for (int k = tid; k < AW; k += NWAVES * 64) lbv[k] = 1.0f / (1.0f + __expf(lb_param[AW + k] - lb_param[k]));
    }
    xcd_barrier(bar);

    {
        pg8::Gemm g{HB, Win_t, M, NIN, D}; pg8::StaticOrder S; S.init(M, NIN, G, (int)blockIdx.x);
        pg8::EpiProj E{PROJ, NIN, vstat, lbv, a_norm_w, RE};
        pg8::gemm_phase<pg8::EpiProj, pg8::StaticOrder, true, true>(L, g, S, E);
    }
    xcd_barrier(bar);

    if (blockIdx.x < 64) {
        FRESH_IDS();
        hgrn2_unit(L, PROJ, RE, HB, blockIdx.x >> 4, blockIdx.x & 15, tid);
    } else {
        const int cb = blockIdx.x - 64, GB = G - 64;
        {   FRESH_IDS();
            for (int u = cb; u < BATCH * 32 * 16; u += GB) gmlp_unit(L, PROJ, vstat, ln_w, ln_b, WSPB, b_sp, HB, u >> 9, (u >> 4) & 31, u & 15, tid); }
        {   pg8::Gemm g{PB, Wple_t, M, D, PLE}; pg8::StaticOrder S; S.init(M, D, GB, cb);
            pg8::EpiBf16<0> E{PW, D, nullptr, 0, 0, 1.f};
            pg8::gemm_phase<pg8::EpiBf16<0>, pg8::StaticOrder, true, true>(L, g, S, E); }
        {   FRESH_IDS();
            LAS float* scr = (LAS float*)(L + wave * 16384);
            constexpr int I_G = (D / 64) * (FF / 32), I_DN = (FF / 64) * (D / 32), I_PG = (D / 64) * (D / 32), NITEMS = 2 * I_G + I_DN + I_PG;
            for (int it = cb * NWAVES + wave; it < NITEMS; it += GB * NWAVES) {
                int r = it;
                if (r < I_G) { const int nb = FF / 32, n0 = 32 * (r % nb); p0_transpose_item(w_gate, D, FF, Wgu_t, 64 * (r / nb), n0, 256 * (n0 >> 7) + (n0 & 127), scr, lane, pre_ffn_w); continue; } r -= I_G;
                if (r < I_G) { const int nb = FF / 32, n0 = 32 * (r % nb); p0_transpose_item(w_up, D, FF, Wgu_t, 64 * (r / nb), n0, 256 * (n0 >> 7) + 128 + (n0 & 127), scr, lane, pre_ffn_w); continue; } r -= I_G;
                if (r < I_DN) { const int nb = D / 32; p0_transpose_item(w_down, FF, D, Wdn_t, 64 * (r / nb), 32 * (r % nb), 32 * (r % nb), scr, lane); continue; } r -= I_DN;
                { const int nb = D / 32; p0_transpose_item(w_pg, D, D, Wpg_t, 64 * (r / nb), 32 * (r % nb), 32 * (r % nb), scr, lane); }
            }
        }
    }
    xcd_barrier(bar);

    {
        pg8::Gemm g{HB, Wout_t, M, D, D}; pg8::StaticOrder S; S.init(M, D, G, (int)blockIdx.x);
        pg8::EpiBf16<0> E{PROJ, D, nullptr, 0, 0, 1.f};
        pg8::gemm_phase<pg8::EpiBf16<0>, pg8::StaticOrder, true, true>(L, g, S, E);
    }
    xcd_barrier(bar);
    { FRESH_IDS(); row_pass<0>(PROJ, x, nullptr, HB, post_mix_w, rs2, gw, NGW, lane); }
    xcd_barrier(bar);

    {
        pg8::Gemm g{HB, Wgu_t, M, NGU, D}; pg8::StaticOrder S; S.init(M, NGU, G, (int)blockIdx.x);
        pg8::EpiSwiGLU E{PROJ, FF, rs2};
        pg8::gemm_phase<pg8::EpiSwiGLU, pg8::StaticOrder, true, true>(L, g, S, E);
    }
    xcd_barrier(bar);

    {
        pg8::Gemm g{PROJ, Wdn_t, M, D, FF}; pg8::StaticOrder S; S.init(M, D, G, (int)blockIdx.x);
        pg8::EpiBf16<0> E{FFB, D, nullptr, 0, 0, 1.f};
        pg8::gemm_phase<pg8::EpiBf16<0>, pg8::StaticOrder, true, true>(L, g, S, E);
    }
    xcd_barrier(bar);
    { FRESH_IDS(); row_pass<1>(FFB, nullptr, nullptr, HB, post_ffn_w, nullptr, gw, NGW, lane); }
    xcd_barrier(bar);

    {
        pg8::Gemm g{HB, Wpg_t, M, D, D}; pg8::StaticOrder S; S.init(M, D, G, (int)blockIdx.x);
        pg8::EpiPleGate E{PW, PROJ, D};
        pg8::gemm_phase<pg8::EpiPleGate, pg8::StaticOrder, true, true>(L, g, S, E);
    }
    xcd_barrier(bar);
    { FRESH_IDS(); row_pass<2>(PROJ, nullptr, out, HB, post_ple_w, nullptr, gw, NGW, lane); }
}

extern "C" void kernel_launch(void* const* d_in, const int* in_sizes, int n_in, void* d_out, int out_size, void* d_ws, size_t ws_size, hipStream_t stream) {
    static int grid = 0;
    if (grid == 0) {
        if (n_in != 20 || in_sizes[0] != M * D || out_size != M * D || ws_size < WS_END) { fprintf(stderr, "kernel_launch: unexpected shapes (n_in %d, in0 %d, out %d, ws %zu); nothing launched\n", n_in, n_in > 0 ? in_sizes[0] : -1, out_size, ws_size); grid = -1; return; }
        int dev = 0, cus = 0, per_cu = 0;
        if (hipGetDevice(&dev) != hipSuccess || hipDeviceGetAttribute(&cus, hipDeviceAttributeMultiprocessorCount, dev) != hipSuccess) { grid = -1; return; }
        if (hipFuncSetAttribute((const void*)hymba_fwd, hipFuncAttributeMaxDynamicSharedMemorySize, LDS_BYTES) != hipSuccess) { fprintf(stderr, "kernel_launch: hipFuncSetAttribute failed\n"); grid = -1; return; }
        if (hipOccupancyMaxActiveBlocksPerMultiprocessor(&per_cu, (const void*)hymba_fwd, NWAVES * 64, LDS_BYTES) != hipSuccess || per_cu < 1) { fprintf(stderr, "kernel_launch: occupancy query reports %d blocks per CU\n", per_cu); }
        (void)hipGetLastError();
        grid = cus;
        if (grid < 128) { fprintf(stderr, "kernel_launch: %d CUs; this kernel deals P2 over 64 + (grid - 64) workgroups and needs a larger device\n", grid); grid = -1; return; }
    }
    if (grid < 0) return;
    if (hipMemsetAsync((char*)d_ws + WS_CTL, 0, CTL_ZERO_BYTES, stream) != hipSuccess) return;
    Args a{};
    for (int i = 0; i < 20; ++i) a.in[i] = (const float*)d_in[i];
    a.out = (float*)d_out; a.ws = (unsigned char*)d_ws;
    hipLaunchKernelGGL(hymba_fwd, dim3(grid), dim3(NWAVES * 64), LDS_BYTES, stream, a);
}
```
